# Optimizing an MI355X kernel written in HIP

```python
import math
import jax, jax.numpy as jnp
from jax import lax
import numpy as np

D_MODEL = 1024
BATCH = 4
SEQ = 8192
DEPTH = 2

N_A_LAYERS = DEPTH // 2
N_B_LAYERS = DEPTH - N_A_LAYERS
CONV_WIDTH = 3
FFN_HIDDEN = -(-8 * D_MODEL // (3 * 256)) * 256
N_HEADS = 16
N_KV_GROUPS = 4
HEADS_PER_GROUP = N_HEADS // N_KV_GROUPS
HEAD_DIM = 64
L_CMP = 32
D_CMP = 16
L_SLC = 64
N_SEL = 16
WINDOW = 512
CMP_HIDDEN = 256
Q_BLOCK = 64
N_KV_SETS = 6
RMS_EPS = 1e-5
NEG_INF = -1e30
FORCE_BONUS = 1e4

kernel_name = "yoco_shortconv_nsa_hybrid"


def rms_norm(x, g):
    xf = x.astype(jnp.float32)
    y = xf * lax.rsqrt(jnp.mean(xf * xf, axis=-1, keepdims=True) + RMS_EPS)
    return (y * g.astype(jnp.float32)).astype(x.dtype)


def short_conv_mixer(h, w_in, conv_w, w_out):
    b_gate, c_gate, v = jnp.split(h @ w_in, 3, axis=-1)
    u = lax.conv_general_dilated(
        c_gate * v, conv_w[:, None, :], window_strides=(1,),
        padding=((CONV_WIDTH - 1, 0),), dimension_numbers=("NWC", "WIO", "NWC"),
        feature_group_count=D_MODEL)
    return (b_gate * u) @ w_out


def swiglu(h, w_gu, w_down):
    g, u = jnp.split(h @ w_gu, 2, axis=-1)
    return (jax.nn.silu(g) * u) @ w_down


def compress(kv_raw, pe, w1, w2):
    bsz, seq = kv_raw.shape[0], kv_raw.shape[1]
    n_cmp = (seq - L_CMP) // D_CMP + 1
    idx = jnp.arange(n_cmp)[:, None] * D_CMP + jnp.arange(L_CMP)[None, :]
    blocks = kv_raw[:, idx] + pe[None, None, :, None, :]
    blocks = blocks.transpose(0, 1, 3, 2, 4).reshape(bsz, n_cmp, N_KV_GROUPS, L_CMP * HEAD_DIM)
    return jax.nn.silu(blocks @ w1) @ w2


def shared_kv(h, kv_norm, w_kv, pe_k, w1_k, w2_k, pe_v, w1_v, w2_v):
    bsz, seq, _ = h.shape
    kv = (rms_norm(h, kv_norm) @ w_kv).reshape(bsz, seq, N_KV_SETS, N_KV_GROUPS, HEAD_DIM)
    k_cmp = compress(kv[:, :, 0], pe_k, w1_k, w2_k)
    v_cmp = compress(kv[:, :, 1], pe_v, w1_v, w2_v)
    return (k_cmp, v_cmp, kv[:, :, 2], kv[:, :, 3], kv[:, :, 4], kv[:, :, 5])


def nsa_mixer(h, w_qg, w_o, k_cmp, v_cmp, k_slc, v_slc, k_win, v_win):
    bsz, seq, _ = h.shape
    G, HPG, dh = N_KV_GROUPS, HEADS_PER_GROUP, HEAD_DIM
    qg = h @ w_qg
    q = (qg[..., :N_HEADS * dh] * (dh ** -0.5)).reshape(bsz, seq, G, HPG, dh)
    gates = jax.nn.sigmoid(qg[..., N_HEADS * dh:].astype(jnp.float32)).reshape(bsz, seq, G, HPG, 3)

    slopes = jnp.exp2(-8.0 * jnp.arange(1, N_HEADS + 1, dtype=jnp.float32) / N_HEADS).reshape(G, HPG)

    n_cmp = k_cmp.shape[1]
    cmp_start = jnp.arange(n_cmp) * D_CMP
    cmp_end = cmp_start + L_CMP - 1
    cmp_center = cmp_end.astype(jnp.float32) - (L_CMP - 1) / 2.0
    n_slc = seq // L_SLC
    n_sel = min(N_SEL, n_slc)
    slc_start = jnp.arange(n_slc) * L_SLC
    overlap = ((cmp_start[:, None] < slc_start[None, :] + L_SLC)
               & (cmp_start[:, None] + L_CMP > slc_start[None, :])).astype(jnp.float32)

    k_blk = k_slc.reshape(bsz, n_slc, L_SLC, G, dh).transpose(0, 3, 1, 2, 4)
    v_blk = v_slc.reshape(bsz, n_slc, L_SLC, G, dh).transpose(0, 3, 1, 2, 4)
    pad = ((0, 0), (WINDOW, 0), (0, 0), (0, 0))
    k_win_pad = jnp.pad(k_win, pad)
    v_win_pad = jnp.pad(v_win, pad)
    b_ix = jnp.arange(bsz)[:, None, None, None]
    g_ix = jnp.arange(G)[None, :, None, None]
    j_blk = jnp.arange(n_slc)

    def one_block(qb):
        q0 = qb * Q_BLOCK
        t = q0 + jnp.arange(Q_BLOCK)
        tf = t.astype(jnp.float32)
        qblk = lax.dynamic_slice_in_dim(q, q0, Q_BLOCK, axis=1)
        gblk = lax.dynamic_slice_in_dim(gates, q0, Q_BLOCK, axis=1)

        s = jnp.einsum("bqghd,bngd->bghqn", qblk, k_cmp).astype(jnp.float32)
        vis = cmp_end[None, :] <= t[:, None]
        s = s - slopes[:, :, None, None] * (tf[:, None] - cmp_center[None, :])
        p_cmp = jax.nn.softmax(jnp.where(vis, s, NEG_INF), axis=-1) * vis
        o_cmp = jnp.einsum("bghqn,bngd->bqghd", p_cmp.astype(v_cmp.dtype), v_cmp)

        imp = jnp.einsum("bghqn,nj->bgqj", p_cmp, overlap)
        cur = t // L_SLC
        valid = j_blk[None, :] <= cur[:, None]
        forced = ((j_blk[None, :] == 0) | (j_blk[None, :] == cur[:, None])
                  | (j_blk[None, :] == cur[:, None] - 1))
        imp = jnp.where(valid, imp + FORCE_BONUS * forced, NEG_INF)
        _, sel = lax.top_k(imp, n_sel)
        k_sel = k_blk[b_ix, g_ix, sel]
        v_sel = v_blk[b_ix, g_ix, sel]
        s = jnp.einsum("bqghd,bgqnld->bghqnl", qblk, k_sel).astype(jnp.float32)
        dist = t[None, None, :, None, None] - (sel[..., None] * L_SLC + jnp.arange(L_SLC))
        dist = dist[:, :, None]
        s = s - slopes[:, :, None, None, None] * dist.astype(jnp.float32)
        s = jnp.where(dist >= 0, s, NEG_INF)
        p = jax.nn.softmax(s.reshape(s.shape[:4] + (n_sel * L_SLC,)), axis=-1).reshape(s.shape)
        o_slc = jnp.einsum("bghqnl,bgqnld->bqghd", p.astype(v_sel.dtype), v_sel)

        kw = lax.dynamic_slice_in_dim(k_win_pad, q0, WINDOW + Q_BLOCK, axis=1)
        vw = lax.dynamic_slice_in_dim(v_win_pad, q0, WINDOW + Q_BLOCK, axis=1)
        spos = q0 - WINDOW + jnp.arange(WINDOW + Q_BLOCK)
        d = t[:, None] - spos[None, :]
        m = (d >= 0) & (d < WINDOW) & (spos >= 0)[None, :]
        s = jnp.einsum("bqghd,bkgd->bghqk", qblk, kw).astype(jnp.float32)
        s = s - slopes[:, :, None, None] * d.astype(jnp.float32)
        p = jax.nn.softmax(jnp.where(m, s, NEG_INF), axis=-1)
        o_win = jnp.einsum("bghqk,bkgd->bqghd", p.astype(vw.dtype), vw)

        o = (gblk[..., 0:1] * o_cmp + gblk[..., 1:2] * o_slc + gblk[..., 2:3] * o_win)
        return o.reshape(bsz, Q_BLOCK, N_HEADS * dh).astype(h.dtype)

    out = lax.map(one_block, jnp.arange(seq // Q_BLOCK))
    out = out.transpose(1, 0, 2, 3).reshape(bsz, seq, N_HEADS * dh)
    return out @ w_o


def setup_inputs(seed: int = 0) -> dict:
    key = jax.random.key(seed)
    ks = jax.random.split(key, 24)

    def w(k, shape, fan_in):
        return jax.random.normal(k, shape, jnp.float32) * (fan_in ** -0.5)

    def gain(k, shape):
        return 1.0 + 0.02 * jax.random.normal(k, shape, jnp.float32)

    D, F = D_MODEL, FFN_HIDDEN
    kv_w = N_KV_GROUPS * HEAD_DIM
    qg_w = N_HEADS * HEAD_DIM + 3 * N_HEADS
    return {
        "x": jax.random.normal(ks[0], (BATCH, SEQ, D), jnp.float32),
        "a_norm": gain(ks[1], (N_A_LAYERS, D)),
        "a_w_in": w(ks[2], (N_A_LAYERS, D, 3 * D), D),
        "a_conv": w(ks[3], (N_A_LAYERS, CONV_WIDTH, D), CONV_WIDTH),
        "a_w_out": w(ks[4], (N_A_LAYERS, D, D), D),
        "kv_norm": gain(ks[5], (D,)),
        "w_kv": w(ks[6], (D, N_KV_SETS * kv_w), D),
        "cmp_pe_k": 0.02 * jax.random.normal(ks[7], (L_CMP, HEAD_DIM), jnp.float32),
        "cmp_w1_k": w(ks[8], (L_CMP * HEAD_DIM, CMP_HIDDEN), L_CMP * HEAD_DIM),
        "cmp_w2_k": w(ks[9], (CMP_HIDDEN, HEAD_DIM), CMP_HIDDEN),
        "cmp_pe_v": 0.02 * jax.random.normal(ks[10], (L_CMP, HEAD_DIM), jnp.float32),
        "cmp_w1_v": w(ks[11], (L_CMP * HEAD_DIM, CMP_HIDDEN), L_CMP * HEAD_DIM),
        "cmp_w2_v": w(ks[12], (CMP_HIDDEN, HEAD_DIM), CMP_HIDDEN),
        "b_norm": gain(ks[13], (N_B_LAYERS, D)),
        "b_w_qg": w(ks[14], (N_B_LAYERS, D, qg_w), D),
        "b_w_o": w(ks[15], (N_B_LAYERS, N_HEADS * HEAD_DIM, D), N_HEADS * HEAD_DIM),
        "f_norm": gain(ks[16], (DEPTH, D)),
        "f_w_gu": w(ks[17], (DEPTH, D, 2 * F), D),
        "f_w_down": w(ks[18], (DEPTH, F, D), F),
        "final_norm": gain(ks[19], (D,)),
    }


def reference(x, a_norm, a_w_in, a_conv, a_w_out, kv_norm, w_kv, cmp_pe_k, cmp_w1_k, cmp_w2_k,
              cmp_pe_v, cmp_w1_v, cmp_w2_v, b_norm, b_w_qg, b_w_o, f_norm, f_w_gu, f_w_down,
              final_norm):
    h = x
    shared = None
    for layer in range(DEPTH):
        if layer < N_A_LAYERS:
            i = layer
            h = h + short_conv_mixer(rms_norm(h, a_norm[i]), a_w_in[i], a_conv[i], a_w_out[i])
        else:
            i = layer - N_A_LAYERS
            if shared is None:
                shared = shared_kv(h, kv_norm, w_kv, cmp_pe_k, cmp_w1_k, cmp_w2_k,
                                   cmp_pe_v, cmp_w1_v, cmp_w2_v)
            k_cmp, v_cmp, k_slc, v_slc, k_win, v_win = shared
            h = h + nsa_mixer(rms_norm(h, b_norm[i]), b_w_qg[i], b_w_o[i],
                              k_cmp, v_cmp, k_slc, v_slc, k_win, v_win)
        h = h + swiglu(rms_norm(h, f_norm[layer]), f_w_gu[layer], f_w_down[layer])
    return rms_norm(h, final_norm)
```

```cpp
#include <hip/hip_runtime.h>
#include <hip/hip_cooperative_groups.h>
#include <cstdio>
namespace cg = cooperative_groups;

#define LAS __attribute__((address_space(3)))
typedef unsigned short bf16_t;
typedef short bf16x8 __attribute__((ext_vector_type(8)));
typedef float f32x4 __attribute__((ext_vector_type(4)));
typedef short bf16x4 __attribute__((ext_vector_type(4)));
typedef unsigned u32x4 __attribute__((ext_vector_type(4)));
typedef unsigned u32x2 __attribute__((ext_vector_type(2)));

constexpr int T = 32768, DM = 1024, SEQ = 8192, FF = 2816;
constexpr float LOG2E = 1.4426950408889634f;
constexpr size_t MBY = 1u << 20;
constexpr size_t WS_PART = 0;
constexpr size_t WS_BAR = 10 * MBY + 512 * 1024;
constexpr size_t WS_KMAX = 10 * MBY + 768 * 1024;
constexpr size_t WS_CBIAS = 11 * MBY;
constexpr size_t WS_WIN = 12 * MBY;
constexpr size_t WS_WOUT = 18 * MBY;
constexpr size_t WS_WGU0 = 20 * MBY;
constexpr size_t WS_WGU1 = 31 * MBY;
constexpr size_t WS_WDN0 = 42 * MBY;
constexpr size_t WS_WDN1 = 48 * MBY;
constexpr size_t WS_WKVQG = 54 * MBY;
constexpr size_t WS_WC1 = 60 * MBY;
constexpr size_t WS_WO = 62 * MBY;
constexpr size_t WS_WC2 = 64 * MBY;
constexpr size_t WS_HB = 65 * MBY;
constexpr size_t WS_HRES = 129 * MBY;
constexpr size_t WS_R = 257 * MBY;
constexpr size_t WS_CV = WS_R, WS_BG = WS_R + 64 * MBY, WS_U = WS_R + 128 * MBY;
constexpr size_t WS_HID = WS_R;
constexpr size_t WS_CMPRAW = WS_R;
constexpr size_t WS_KSLC = WS_R + 33 * MBY, WS_VSLC = WS_R + 49 * MBY, WS_KWIN = WS_R + 65 * MBY, WS_VWIN = WS_R + 81 * MBY;
constexpr size_t WS_Q = WS_R + 97 * MBY;
constexpr size_t WS_GATES = WS_R + 161 * MBY;
constexpr size_t WS_CHID = WS_R + 168 * MBY;
constexpr size_t WS_KCMP = WS_R + 176 * MBY;
constexpr size_t WS_VCMP = WS_R + 177 * MBY;
constexpr size_t WS_O = WS_R + 178 * MBY;
constexpr int LDS_BYTES = 155648;

struct Params { const float* in[20]; float* out; unsigned char* ws; int ph_lo, ph_hi; };

typedef float f32x2_t __attribute__((ext_vector_type(2)));
typedef __bf16 bf16x2_t __attribute__((ext_vector_type(2)));
__device__ __forceinline__ unsigned cvt_pk_bf16(float lo, float hi) { const f32x2_t v = {lo, hi}; const bf16x2_t b = __builtin_convertvector(v, bf16x2_t); return __builtin_bit_cast(unsigned, b); }
__device__ __forceinline__ bf16_t f2bf_sw(float f) { return (bf16_t)(cvt_pk_bf16(f, f) & 0xffffu); }
__device__ __forceinline__ float bf_lo(unsigned w) { return __uint_as_float(w << 16); }
__device__ __forceinline__ float bf_hi(unsigned w) { return __uint_as_float(w & 0xffff0000u); }
__device__ __forceinline__ u32x4 pack8(const f32x4 a, const f32x4 b) { u32x4 w; w.x = cvt_pk_bf16(a[0], a[1]); w.y = cvt_pk_bf16(a[2], a[3]); w.z = cvt_pk_bf16(b[0], b[1]); w.w = cvt_pk_bf16(b[2], b[3]); return w; }
__device__ __forceinline__ float row_rstd(const float* part, int r) {
    const f32x4* p = (const f32x4*)(part + (size_t)r * 16);
    const f32x4 s = (p[0] + p[1]) + (p[2] + p[3]);
    return rsqrtf(((s[0] + s[1]) + (s[2] + s[3])) * (1.0f / 1024.0f) + 1e-5f);
}
__device__ __forceinline__ float xsum_16_32(float x) { x += __shfl_xor(x, 16); x += __shfl_xor(x, 32); return x; }
__device__ __forceinline__ float xmax_16_32(float x) { x = fmaxf(x, __shfl_xor(x, 16)); x = fmaxf(x, __shfl_xor(x, 32)); return x; }
__device__ __forceinline__ void rows_rstd(const float* part, int row0, int fq, float (&rs)[2][4]) {
    f32x4 q[2][4];
#pragma unroll
    for (int ai = 0; ai < 2; ++ai)
#pragma unroll
        for (int m = 0; m < 4; ++m) q[ai][m] = ((const f32x4*)(part + (size_t)(row0 + ai * 128 + m * 16) * 16))[fq];
#pragma unroll
    for (int ai = 0; ai < 2; ++ai)
#pragma unroll
        for (int m = 0; m < 4; ++m) {
            float t = (q[ai][m][0] + q[ai][m][1]) + (q[ai][m][2] + q[ai][m][3]);
            t = xsum_16_32(t);
            rs[ai][m] = rsqrtf(t * (1.0f / 1024.0f) + 1e-5f);
        }
}
__device__ __forceinline__ float fast_rcp(float x) { return __builtin_amdgcn_rcpf(x); }
__device__ __forceinline__ float sigmoid_f(float g) { return fast_rcp(1.0f + __builtin_amdgcn_exp2f(g * -LOG2E)); }
__device__ __forceinline__ float silu_f(float g) { return g * sigmoid_f(g); }

namespace pg8 {
constexpr int BM = 256, BK = 64, HALF = 128, HTB = HALF * BK * 2, NXCD = 8, WGM = 8;
__device__ __forceinline__ int lds_byte(int r, int c) { const int st = (r >> 4) * 2 + (c >> 5), rr = r & 15, cc = c & 31, ob = rr * 64 + cc * 2; return st * 1024 + (ob ^ (((ob >> 9) & 1) << 5)); }
__device__ __forceinline__ void stage_rc(int b, int& R, int& C) { const int st = b / 1024, sb = b % 1024, swz = sb ^ (((sb >> 9) & 1) << 5); R = (st >> 1) * 16 + swz / 64; C = (st & 1) * 32 + (swz % 64) / 2; }
__device__ __forceinline__ int perm32(int rho) { const int n = rho >> 4, i = rho & 15; return 8 * (i >> 2) + 4 * n + (i & 3); }
struct Unit { int pm, pn, ar; };
struct Gemm { const bf16_t* A; const bf16_t* Bt; int lda, K; };
struct StaticOrder {
    int nM, nN, nwg, G, c;
    __device__ void init(int M, int N, int G_, int c_) { nM = M / BM; nN = N / BM; nwg = nM * nN; G = G_; c = c_; }
    __device__ bool next(int i, Unit& u) const {
        const long L = (long)i * G + c; if (L >= nwg) return false;
        int wgid = (int)L; { const int q = nwg / NXCD, r = nwg % NXCD, xcd = wgid % NXCD, off = wgid / NXCD; wgid = (xcd < r ? xcd * (q + 1) : r * (q + 1) + (xcd - r) * q) + off; }
        const int nig = WGM * nN, gid = wgid / nig, fm = gid * WGM, gsz = (nM - fm) < WGM ? (nM - fm) : WGM;
        u.pm = fm + ((wgid % nig) % gsz); u.pn = (wgid % nig) / gsz; u.ar = 0; return true;
    }
};
struct CmpOrder {
    int G, c;
    __device__ bool next(int i, Unit& u) const { const int L = i * G + c; if (L >= 128) return false; u.pm = L >> 1; u.ar = L & 1; u.pn = (u.pm >> 5) * 2 + (L & 1); return true; }
};

struct GateOrder {
    int G, c;
    __device__ bool next(int i, Unit& u) const { const int L = i * G + c; if (L >= 128) return false; u.pm = L; u.pn = 10; u.ar = 0; return true; }
};
template <class Epi, class Sched>
__device__ __forceinline__ void gemm_phase(LAS unsigned char* lds, const Gemm g, const Sched& S, const Epi& E) {
    const int tid = threadIdx.x, wid = __builtin_amdgcn_readfirstlane(tid >> 6), lane = tid & 63, wr = wid >> 2, wc = wid & 3, fr = lane & 15, fq = lane >> 4;
    const int K = g.K, nt = K / BK;
    unsigned voffA[2], voffB[2];
#pragma unroll
    for (int i = 0; i < 2; ++i) { int R, C; stage_rc(tid * 16 + i * 8192, R, C); const int Rb = (R & ~31) + perm32(R & 31);
        voffA[i] = (unsigned)(R * g.lda + C) * 2u; voffB[i] = (unsigned)(Rb * K + C) * 2u; }
    const size_t kstep = (size_t)(BK * 2);
    const size_t hstepA = (size_t)HALF * g.lda * 2, hstepB = (size_t)HALF * K * 2;
    const size_t tstepA = 2 * hstepA, tstepB = 2 * hstepB;
    const unsigned ldsw = (unsigned)wid * 1024u;
    const int aoff = lds_byte(wr * 64 + fr, fq * 8), boff = lds_byte(wc * 32 + fr, fq * 8);
#define PG8_SA(b, h) (((b) * 2 + (h)) * HTB)
#define PG8_SB(b, h) ((4 + (b) * 2 + (h)) * HTB)
#define PG8_STAGE(bufoff, gbase, voff) do { _Pragma("unroll") for (int _i = 0; _i < 2; ++_i) \
        __builtin_amdgcn_global_load_lds((const unsigned*)((const char*)(gbase) + (voff)[_i]), (LAS unsigned*)(lds + (bufoff) + ldsw + _i * 8192), 16, 0, 0); } while (0)
#define PG8_LDA(dst, b, h) do { _Pragma("unroll") for (int m = 0; m < 4; ++m) _Pragma("unroll") for (int k = 0; k < 2; ++k) dst[m][k] = *(const LAS bf16x8*)(lds + PG8_SA(b, h) + aoff + m * 2048 + k * 1024); } while (0)
#define PG8_LDB(dst, b, h) do { _Pragma("unroll") for (int n = 0; n < 2; ++n) _Pragma("unroll") for (int k = 0; k < 2; ++k) dst[n][k] = *(const LAS bf16x8*)(lds + PG8_SB(b, h) + boff + n * 2048 + k * 1024); } while (0)
#define PG8_MMA(ai, bj, At, Bt) do { __builtin_amdgcn_s_setprio(1); _Pragma("unroll") for (int m = 0; m < 4; ++m) _Pragma("unroll") for (int n = 0; n < 2; ++n) _Pragma("unroll") for (int k = 0; k < 2; ++k) \
        acc[ai][bj][m][n] = __builtin_amdgcn_mfma_f32_16x16x32_bf16(Bt[n][k], At[m][k], acc[ai][bj][m][n], 0, 0, 0); __builtin_amdgcn_s_setprio(0); } while (0)
#define PG8_WAIT_V(n) asm volatile("s_waitcnt vmcnt(" #n ")" ::: "memory")
#define PG8_WAIT_L(n) asm volatile("s_waitcnt lgkmcnt(" #n ")" ::: "memory")
#define PG8_BAR __builtin_amdgcn_s_barrier()
#define PG8_SCHED __builtin_amdgcn_sched_barrier(0)
    Unit cur, nxt; int ui = 0;
    if (!S.next(0, cur)) return;
    f32x4 acc[2][2][4][2];
#pragma unroll
    for (int a = 0; a < 2; ++a)
#pragma unroll
        for (int b = 0; b < 2; ++b)
#pragma unroll
            for (int m = 0; m < 4; ++m)
#pragma unroll
                for (int n = 0; n < 2; ++n) acc[a][b][m][n] = (f32x4){0.f, 0.f, 0.f, 0.f};
    bf16x8 At[4][2], B0[2][2], B1[2][2];
    const char* cA = (const char*)g.A + (size_t)cur.pm * tstepA + (size_t)cur.ar * g.lda * 2; const char* cB = (const char*)g.Bt + (size_t)cur.pn * tstepB;
    LAS unsigned char* rsimg = lds + 131072 + wr * 8192;
    if constexpr (Epi::NEEDS_RS) E.pre(cur, rsimg, wid, wr, lane);
    PG8_STAGE(PG8_SB(0, 0), cB, voffB); PG8_STAGE(PG8_SA(0, 0), cA, voffA); PG8_STAGE(PG8_SB(0, 1), cB + hstepB, voffB); PG8_STAGE(PG8_SA(0, 1), cA + hstepA, voffA);
    if (wr == 1) PG8_BAR;
    PG8_WAIT_V(4); PG8_BAR;
    PG8_STAGE(PG8_SB(1, 0), cB + kstep, voffB); PG8_STAGE(PG8_SA(1, 0), cA + kstep, voffA); PG8_STAGE(PG8_SB(1, 1), cB + hstepB + kstep, voffB);
    PG8_WAIT_V(6); PG8_BAR;
    for (;;) {
        const bool has_next = S.next(ui + 1, nxt);
        const char* nA = has_next ? (const char*)g.A + (size_t)nxt.pm * tstepA + (size_t)nxt.ar * g.lda * 2 : cA; const char* nB = has_next ? (const char*)g.Bt + (size_t)nxt.pn * tstepB : cB;
        for (int t = 0; t < nt; t += 2) {
            const bool last = (t == nt - 2);
            const char* a1 = cA + (size_t)(t + 1) * kstep;
            const char* a2 = last ? nA : cA + (size_t)(t + 2) * kstep; const char* b2 = last ? nB : cB + (size_t)(t + 2) * kstep;
            const char* a3 = a2 + kstep; const char* b3 = b2 + kstep;
            PG8_LDB(B0, 0, 0); PG8_SCHED; PG8_LDA(At, 0, 0); PG8_STAGE(PG8_SA(1, 1), a1 + hstepA, voffA);
            PG8_WAIT_L(8); PG8_BAR; PG8_WAIT_L(0); PG8_MMA(0, 0, At, B0); PG8_BAR; PG8_SCHED;
            PG8_LDB(B1, 0, 1); PG8_STAGE(PG8_SB(0, 0), b2, voffB);
            PG8_BAR; PG8_WAIT_L(0); PG8_MMA(0, 1, At, B1); PG8_BAR;
            PG8_LDA(At, 0, 1); PG8_STAGE(PG8_SA(0, 0), a2, voffA);
            PG8_BAR; PG8_WAIT_L(0); PG8_MMA(1, 0, At, B0); PG8_BAR; PG8_SCHED;
            PG8_STAGE(PG8_SB(0, 1), b2 + hstepB, voffB);
            PG8_WAIT_V(6); PG8_BAR; PG8_MMA(1, 1, At, B1); PG8_BAR;
            PG8_LDB(B0, 1, 0); PG8_SCHED; PG8_LDA(At, 1, 0); PG8_STAGE(PG8_SA(0, 1), a2 + hstepA, voffA);
            PG8_WAIT_L(8); PG8_BAR; PG8_WAIT_L(0); PG8_MMA(0, 0, At, B0); PG8_BAR; PG8_SCHED;
            PG8_LDB(B1, 1, 1); PG8_STAGE(PG8_SB(1, 0), b3, voffB);
            PG8_BAR; PG8_WAIT_L(0); PG8_MMA(0, 1, At, B1); PG8_BAR;
            PG8_LDA(At, 1, 1); PG8_STAGE(PG8_SA(1, 0), a3, voffA);
            PG8_BAR; PG8_WAIT_L(0); PG8_MMA(1, 0, At, B0); PG8_BAR; PG8_SCHED;
            PG8_STAGE(PG8_SB(1, 1), b3 + hstepB, voffB);
            PG8_WAIT_V(6); PG8_BAR; PG8_MMA(1, 1, At, B1); PG8_BAR;
        }
        if constexpr (Epi::NEEDS_RS) {
            float rsa[2][4];
            {
                f32x4 q[2][4];
#pragma unroll
                for (int ai = 0; ai < 2; ++ai)
#pragma unroll
                    for (int m = 0; m < 4; ++m) q[ai][m] = *(const LAS f32x4*)(rsimg + (ai * 4 + m) * 1024 + fq * 256 + fr * 16);
#pragma unroll
                for (int ai = 0; ai < 2; ++ai)
#pragma unroll
                    for (int m = 0; m < 4; ++m) { const float t4 = xsum_16_32((q[ai][m][0] + q[ai][m][1]) + (q[ai][m][2] + q[ai][m][3])); rsa[ai][m] = rsqrtf(t4 * (1.0f / 1024.0f) + 1e-5f); }
                asm volatile("s_waitcnt lgkmcnt(0)" ::: "memory"); PG8_BAR; asm volatile("" ::: "memory");
                if (has_next) E.pre(nxt, rsimg, wid, wr, lane);
            }
            E(acc, cur, wr, wc, fr, fq, rsa);
        } else E(acc, cur, wr, wc, fr, fq);
        if (!has_next) break;
#pragma unroll
        for (int a = 0; a < 2; ++a)
#pragma unroll
            for (int b = 0; b < 2; ++b)
#pragma unroll
                for (int m = 0; m < 4; ++m)
#pragma unroll
                    for (int n = 0; n < 2; ++n) acc[a][b][m][n] = (f32x4){0.f, 0.f, 0.f, 0.f};
        cur = nxt; cA = nA; cB = nB; ++ui;
    }
    PG8_WAIT_V(0);
    if (wr == 0) PG8_BAR;
    PG8_BAR;
#undef PG8_SA
#undef PG8_SB
#undef PG8_STAGE
#undef PG8_LDA
#undef PG8_LDB
#undef PG8_MMA
#undef PG8_WAIT_V
#undef PG8_WAIT_L
#undef PG8_BAR
#undef PG8_SCHED
}
}
using pg8::Unit;
typedef f32x4 AccT[2][2][4][2];

struct EpiWin {
    const float* part; bf16_t* cv; bf16_t* bg;
        static constexpr bool NEEDS_RS = true;
    __device__ __forceinline__ void pre(const Unit& u, LAS unsigned char* img, int wid, int wr, int lane) const {
#pragma unroll
        for (int k = 0; k < 2; ++k) {
            const int L = k * 4096 + (wid & 3) * 1024 + lane * 16, gq = L >> 10, c = (L >> 8) & 3, rr = (L >> 4) & 15, hl = gq * 16 + rr;
            const int row = u.pm * 256 + (hl >> 6) * 128 + wr * 64 + (hl & 63);
            __builtin_amdgcn_global_load_lds((const unsigned*)(part + (size_t)row * 16 + c * 4), (LAS unsigned*)(img + k * 4096 + (wid & 3) * 1024), 16, 0, 0);
        }
    }
    __device__ __forceinline__ void operator()(const AccT& acc, const Unit& u, int wr, int wc, int fr, int fq, const float (&rsa)[2][4]) const {
        const int row0 = u.pm * 256 + wr * 64 + fr, cbase = wc * 32 + 8 * fq;
#pragma unroll
        for (int ai = 0; ai < 2; ++ai)
#pragma unroll
            for (int m = 0; m < 4; ++m) {
                const int r = row0 + ai * 128 + m * 16; const float rs = rsa[ai][m];
                if (u.pn < 8) { const float rs2 = rs * rs;
                    *(u32x4*)(cv + (size_t)r * 1024 + u.pn * 128 + cbase) = pack8(acc[ai][0][m][0] * acc[ai][1][m][0] * rs2, acc[ai][0][m][1] * acc[ai][1][m][1] * rs2);
                } else {
#pragma unroll
                    for (int bj = 0; bj < 2; ++bj) *(u32x4*)(bg + (size_t)r * 1024 + (u.pn - 8) * 256 + bj * 128 + cbase) = pack8(acc[ai][bj][m][0] * rs, acc[ai][bj][m][1] * rs);
                }
            }
    }
};
struct EpiRes {
    static constexpr bool NEEDS_RS = false;
    const float* resid; float* hout; bf16_t* hb; float* part_out;
    __device__ __forceinline__ void operator()(const AccT& acc, const Unit& u, int wr, int wc, int fr, int fq) const {
        const int row0 = u.pm * 256 + wr * 64 + fr, cbase = wc * 32 + 8 * fq;
#pragma unroll
        for (int ai = 0; ai < 2; ++ai) {
          f32x4 rv[4][2][2];
#pragma unroll
          for (int m = 0; m < 4; ++m)
#pragma unroll
              for (int bj = 0; bj < 2; ++bj) { const size_t off = (size_t)(row0 + ai * 128 + m * 16) * 1024 + u.pn * 256 + bj * 128 + cbase;
                  rv[m][bj][0] = *(const f32x4*)(resid + off); rv[m][bj][1] = *(const f32x4*)(resid + off + 4); }
#pragma unroll
            for (int m = 0; m < 4; ++m) {
                const int r = row0 + ai * 128 + m * 16; float ss = 0.f;
#pragma unroll
                for (int bj = 0; bj < 2; ++bj) {
                    const size_t off = (size_t)r * 1024 + u.pn * 256 + bj * 128 + cbase;
                    const f32x4 v0 = rv[m][bj][0] + acc[ai][bj][m][0], v1 = rv[m][bj][1] + acc[ai][bj][m][1];
                    *(f32x4*)(hout + off) = v0; *(f32x4*)(hout + off + 4) = v1;
                    if (hb) *(u32x4*)(hb + off) = pack8(v0, v1);
                    ss += (v0[0] * v0[0] + v0[1] * v0[1]) + (v0[2] * v0[2] + v0[3] * v0[3]) + (v1[0] * v1[0] + v1[1] * v1[1]) + (v1[2] * v1[2] + v1[3] * v1[3]);
                }
                ss = xsum_16_32(ss);
                if (fq == 0) part_out[(size_t)r * 16 + u.pn * 4 + wc] = ss;
            }
        }
    }
};
struct EpiResB {
    static constexpr bool NEEDS_RS = false;
    bf16_t* hb; float* part_out;
    __device__ __forceinline__ void operator()(const AccT& acc, const Unit& u, int wr, int wc, int fr, int fq) const {
        const int row0 = u.pm * 256 + wr * 64 + fr, cbase = wc * 32 + 8 * fq;
#pragma unroll
        for (int ai = 0; ai < 2; ++ai) {
            u32x4 rv[4][2];
#pragma unroll
            for (int m = 0; m < 4; ++m)
#pragma unroll
                for (int bj = 0; bj < 2; ++bj) rv[m][bj] = *(const u32x4*)(hb + (size_t)(row0 + ai * 128 + m * 16) * 1024 + u.pn * 256 + bj * 128 + cbase);
#pragma unroll
            for (int m = 0; m < 4; ++m) {
                const int r = row0 + ai * 128 + m * 16; float ss = 0.f;
#pragma unroll
                for (int bj = 0; bj < 2; ++bj) {
                    const u32x4 w = rv[m][bj];
                    const f32x4 v0 = (f32x4){bf_lo(w.x), bf_hi(w.x), bf_lo(w.y), bf_hi(w.y)} + acc[ai][bj][m][0];
                    const f32x4 v1 = (f32x4){bf_lo(w.z), bf_hi(w.z), bf_lo(w.w), bf_hi(w.w)} + acc[ai][bj][m][1];
                    *(u32x4*)(hb + (size_t)r * 1024 + u.pn * 256 + bj * 128 + cbase) = pack8(v0, v1);
                    ss += (v0[0] * v0[0] + v0[1] * v0[1]) + (v0[2] * v0[2] + v0[3] * v0[3]) + (v1[0] * v1[0] + v1[1] * v1[1]) + (v1[2] * v1[2] + v1[3] * v1[3]);
                }
                ss = xsum_16_32(ss);
                if (fq == 0) part_out[(size_t)r * 16 + u.pn * 4 + wc] = ss;
            }
        }
    }
};
struct EpiGu {
    const float* part; bf16_t* hid;
        static constexpr bool NEEDS_RS = true;
    __device__ __forceinline__ void pre(const Unit& u, LAS unsigned char* img, int wid, int wr, int lane) const {
#pragma unroll
        for (int k = 0; k < 2; ++k) {
            const int L = k * 4096 + (wid & 3) * 1024 + lane * 16, gq = L >> 10, c = (L >> 8) & 3, rr = (L >> 4) & 15, hl = gq * 16 + rr;
            const int row = u.pm * 256 + (hl >> 6) * 128 + wr * 64 + (hl & 63);
            __builtin_amdgcn_global_load_lds((const unsigned*)(part + (size_t)row * 16 + c * 4), (LAS unsigned*)(img + k * 4096 + (wid & 3) * 1024), 16, 0, 0);
        }
    }
    __device__ __forceinline__ void operator()(const AccT& acc, const Unit& u, int wr, int wc, int fr, int fq, const float (&rsa)[2][4]) const {
        const int row0 = u.pm * 256 + wr * 64 + fr, cbase = wc * 32 + 8 * fq;
#pragma unroll
        for (int ai = 0; ai < 2; ++ai)
#pragma unroll
            for (int m = 0; m < 4; ++m) {
                const int r = row0 + ai * 128 + m * 16; const float rs = rsa[ai][m];
                f32x4 o[2];
#pragma unroll
                for (int n = 0; n < 2; ++n)
#pragma unroll
                    for (int j = 0; j < 4; ++j) { const float gg = acc[ai][0][m][n][j] * rs, uu = acc[ai][1][m][n][j] * rs; o[n][j] = silu_f(gg) * uu; }
                *(u32x4*)(hid + (size_t)r * FF + u.pn * 128 + cbase) = pack8(o[0], o[1]);
            }
    }
};
struct EpiKvqg {
    const float* part; unsigned char* ws;
        static constexpr bool NEEDS_RS = true;
    __device__ __forceinline__ void pre(const Unit& u, LAS unsigned char* img, int wid, int wr, int lane) const {
#pragma unroll
        for (int k = 0; k < 2; ++k) {
            const int L = k * 4096 + (wid & 3) * 1024 + lane * 16, gq = L >> 10, c = (L >> 8) & 3, rr = (L >> 4) & 15, hl = gq * 16 + rr;
            const int row = u.pm * 256 + (hl >> 6) * 128 + wr * 64 + (hl & 63);
            __builtin_amdgcn_global_load_lds((const unsigned*)(part + (size_t)row * 16 + c * 4), (LAS unsigned*)(img + k * 4096 + (wid & 3) * 1024), 16, 0, 0);
        }
    }
    __device__ __forceinline__ void operator()(const AccT& acc, const Unit& u, int wr, int wc, int fr, int fq, const float (&rsa)[2][4]) const {
        const int row0 = u.pm * 256 + wr * 64 + fr, cbase = wc * 32 + 8 * fq;
#pragma unroll
        for (int ai = 0; ai < 2; ++ai)
#pragma unroll
            for (int m = 0; m < 4; ++m) {
                const int r = row0 + ai * 128 + m * 16; const float rs = rsa[ai][m];
                const int b = r >> 13, s = r & 8191;
#pragma unroll
                for (int bj = 0; bj < 2; ++bj) {
                    const int col = bj * 128 + cbase;
                    const f32x4 v0 = acc[ai][bj][m][0] * rs, v1 = acc[ai][bj][m][1] * rs;
                    if (u.pn < 6) {
                        const int gi = col >> 6, d = col & 63, bgi = b * 4 + gi;
                        if (u.pn < 2) { *(u32x4*)((bf16_t*)(ws + WS_CMPRAW) + ((size_t)(u.pn * 16 + bgi) * SEQ + s) * 64 + d) = pack8(v0, v1); }
                        else if (u.pn == 2 || u.pn == 4) { *(u32x4*)((bf16_t*)(ws + (u.pn == 2 ? WS_KSLC : WS_KWIN)) + ((size_t)bgi * SEQ + s) * 64 + d) = pack8(v0, v1); }
                        else { bf16_t* vt = (bf16_t*)(ws + (u.pn == 3 ? WS_VSLC : WS_VWIN)) + ((size_t)(bgi * 128 + (s >> 6)) * 64 + d) * 64 + (s & 63);
                            const u32x4 w = pack8(v0, v1);
                            vt[0 * 64] = (bf16_t)(w.x & 0xffff); vt[1 * 64] = (bf16_t)(w.x >> 16); vt[2 * 64] = (bf16_t)(w.y & 0xffff); vt[3 * 64] = (bf16_t)(w.y >> 16);
                            vt[4 * 64] = (bf16_t)(w.z & 0xffff); vt[5 * 64] = (bf16_t)(w.z >> 16); vt[6 * 64] = (bf16_t)(w.w & 0xffff); vt[7 * 64] = (bf16_t)(w.w >> 16); }
                    } else if (u.pn < 10) {
                        const float qs = 0.125f * LOG2E;
                        *(u32x4*)((bf16_t*)(ws + WS_Q) + (size_t)r * 1024 + (u.pn - 6) * 256 + col) = pack8(v0 * qs, v1 * qs);
                    } else {
                        if (col < 48) { float* gp = (float*)(ws + WS_GATES) + (size_t)r * 48 + col;
                            f32x4 a, c2;
#pragma unroll
                            for (int j = 0; j < 4; ++j) { a[j] = sigmoid_f(v0[j]); c2[j] = sigmoid_f(v1[j]); }
                            *(f32x4*)gp = a; *(f32x4*)(gp + 4) = c2; }
                    }
                }
            }
    }
};
struct EpiCmp {
    static constexpr bool NEEDS_RS = false;
    bf16_t* pbuf;
    __device__ __forceinline__ void operator()(const AccT& acc, const Unit& u, int wr, int wc, int fr, int fq) const {
        const int row0 = u.pm * 256 + wr * 64 + fr, cbase = wc * 32 + 8 * fq;
        bf16_t* base = pbuf + (size_t)(u.pn & 1) * 16384 * 256;
#pragma unroll
        for (int ai = 0; ai < 2; ++ai)
#pragma unroll
            for (int m = 0; m < 4; ++m) {
                const int r = row0 + ai * 128 + m * 16;
#pragma unroll
                for (int bj = 0; bj < 2; ++bj) *(u32x4*)(base + (size_t)r * 256 + bj * 128 + cbase) = pack8(acc[ai][bj][m][0], acc[ai][bj][m][1]);
            }
    }
};

__device__ __forceinline__ void transpose_item(const float* W, int K, int Nsrc, bf16_t* dst, int kind, const float* gain, int item, LAS float* scr, int nN64) {
    const int tid = threadIdx.x;
    const int kb = item / nN64, nb = item % nN64, k0 = kb * 64, nd0 = nb * 64;
    int ns0 = nd0;
    if (kind == 1) { if (nd0 < 2048) { const int pn = nd0 >> 8, half = (nd0 >> 7) & 1, c = nd0 & 127; ns0 = 1024 + half * 1024 + pn * 128 + c; } else ns0 = nd0 - 2048; }
    else if (kind == 2) { const int pn = nd0 >> 8, half = (nd0 >> 7) & 1, c = nd0 & 127; ns0 = half * FF + pn * 128 + c; }
    const int kk = tid >> 4, n4 = (tid & 15) * 4;
#pragma unroll
    for (int i = 0; i < 2; ++i) {
        const int k = k0 + kk + 32 * i;
        f32x4 v = (f32x4){0.f, 0.f, 0.f, 0.f};
        if (ns0 + n4 < Nsrc) v = *(const f32x4*)(W + (size_t)k * Nsrc + ns0 + n4);
        if (gain) v = v * gain[k];
        LAS float* sp = scr + (kk + 32 * i) * 65 + n4;
        sp[0] = v[0]; sp[1] = v[1]; sp[2] = v[2]; sp[3] = v[3];
    }
    __syncthreads();
    const int n = tid >> 3, kc = (tid & 7) * 8;
    const LAS float* s = scr + kc * 65 + n;
    u32x4 o; o.x = cvt_pk_bf16(s[0], s[65]); o.y = cvt_pk_bf16(s[2 * 65], s[3 * 65]); o.z = cvt_pk_bf16(s[4 * 65], s[5 * 65]); o.w = cvt_pk_bf16(s[6 * 65], s[7 * 65]);
    *(u32x4*)(dst + (size_t)(nd0 + n) * K + k0 + kc) = o;
    __syncthreads();
}
__device__ __forceinline__ void prep_phase(const Params& p, LAS unsigned char* lds) {
    LAS float* scr = (LAS float*)lds;
    unsigned char* ws = p.ws;
    const int G = gridDim.x, bx = blockIdx.x, tid = threadIdx.x, lane = tid & 63, wv = tid >> 6;
    constexpr int NW = 15;
    const float* srcs[NW] = {p.in[2], p.in[4], p.in[17], p.in[17] + (size_t)1024 * 5632, p.in[18], p.in[18] + (size_t)FF * 1024, p.in[6], p.in[14], p.in[8], p.in[11], p.in[15], p.in[9], p.in[12],
                             p.in[8] + (size_t)1024 * 256, p.in[11] + (size_t)1024 * 256};
    const int Ks[NW] = {1024, 1024, 1024, 1024, FF, FF, 1024, 1024, 1024, 1024, 1024, 256, 256, 1024, 1024};
    const int Nsrcs[NW] = {3072, 1024, 5632, 5632, 1024, 1024, 1536, 1072, 256, 256, 1024, 64, 64, 256, 256};
    const int Ndsts[NW] = {3072, 1024, 5632, 5632, 1024, 1024, 1536, 1280, 256, 256, 1024, 64, 64, 256, 256};
    const size_t dsts[NW] = {WS_WIN, WS_WOUT, WS_WGU0, WS_WGU1, WS_WDN0, WS_WDN1, WS_WKVQG, WS_WKVQG + (size_t)1536 * 1024 * 2, WS_WC1, WS_WC1 + (size_t)2 * 256 * 1024 * 2, WS_WO, WS_WC2, WS_WC2 + 64 * 256 * 2,
                             WS_WC1 + (size_t)1 * 256 * 1024 * 2, WS_WC1 + (size_t)3 * 256 * 1024 * 2};
    const int kinds[NW] = {1, 0, 2, 2, 0, 0, 0, 0, 0, 0, 0, 0, 0, 0, 0};
    const float* gains[NW] = {p.in[1], nullptr, p.in[16], p.in[16] + 1024, nullptr, nullptr, p.in[5], p.in[13], nullptr, nullptr, nullptr, nullptr, nullptr, nullptr, nullptr};
    int base = 0;
#pragma unroll
    for (int wi = 0; wi < NW; ++wi) {
        const int nN64 = Ndsts[wi] / 64, nitems = (Ks[wi] / 64) * nN64;
        int first = (bx - base % G + G) % G;
        for (int it = first; it < nitems; it += G) transpose_item(srcs[wi], Ks[wi], Nsrcs[wi], (bf16_t*)(ws + dsts[wi]), kinds[wi], gains[wi], it, scr, nN64);
        base += nitems;
    }
    {
        const float* x = p.in[0]; bf16_t* hb = (bf16_t*)(ws + WS_HB); float* part = (float*)(ws + WS_PART);
        for (int r = bx * 8 + wv; r < T; r += G * 8) {
            const f32x4* xr = (const f32x4*)(x + (size_t)r * 1024);
            float ss = 0.f;
#pragma unroll
            for (int j = 0; j < 2; ++j) {
                const f32x4 a = xr[j * 128 + lane * 2], b = xr[j * 128 + lane * 2 + 1];
                ss += (a[0] * a[0] + a[1] * a[1]) + (a[2] * a[2] + a[3] * a[3]) + (b[0] * b[0] + b[1] * b[1]) + (b[2] * b[2] + b[3] * b[3]);
                *(u32x4*)(hb + (size_t)r * 1024 + j * 512 + lane * 8) = pack8(a, b);
            }
#pragma unroll
            for (int o = 1; o < 64; o <<= 1) ss += __shfl_xor(ss, o);
            if (lane < 16) part[(size_t)r * 16 + lane] = (lane == 0) ? ss : 0.f;
        }
    }
    if (bx == 0) { unsigned* bw = (unsigned*)(ws + WS_BAR); for (int i = tid; i < 3456; i += 512) __hip_atomic_store(bw + i, 0u, __ATOMIC_RELAXED, __HIP_MEMORY_SCOPE_AGENT); }
    if (bx == 1 && tid < 17) __hip_atomic_store((unsigned*)(ws + WS_KMAX) + tid, 0u, __ATOMIC_RELAXED, __HIP_MEMORY_SCOPE_AGENT);
    if (bx < 2 && tid < 256) {
        const float* pe = p.in[bx == 0 ? 7 : 10]; const float* w1 = p.in[bx == 0 ? 8 : 11];
        float a = 0.f;
        for (int i = 0; i < 2048; ++i) a += pe[i] * w1[(size_t)i * 256 + tid];
        ((float*)(ws + WS_CBIAS))[bx * 256 + tid] = a;
    }
}

__device__ __forceinline__ void conv_phase(const Params& p) {
    unsigned char* ws = p.ws;
    const bf16_t* cv = (const bf16_t*)(ws + WS_CV); const bf16_t* bg = (const bf16_t*)(ws + WS_BG); bf16_t* uo = (bf16_t*)(ws + WS_U);
    const float* cw = p.in[3];
    const size_t total = (size_t)T * 128, stride = (size_t)gridDim.x * 512;
    for (size_t idx = (size_t)blockIdx.x * 512 + threadIdx.x; idx < total; idx += stride) {
        const int t = (int)(idx >> 7), c8 = (int)(idx & 127) * 8, s = t & 8191;
        const u32x4 z = (u32x4){0u, 0u, 0u, 0u};
        const u32x4 x2 = *(const u32x4*)(cv + (size_t)t * 1024 + c8);
        const u32x4 x1 = s >= 1 ? *(const u32x4*)(cv + (size_t)(t - 1) * 1024 + c8) : z;
        const u32x4 x0 = s >= 2 ? *(const u32x4*)(cv + (size_t)(t - 2) * 1024 + c8) : z;
        const u32x4 bb = *(const u32x4*)(bg + (size_t)t * 1024 + c8);
        const f32x4 w0a = *(const f32x4*)(cw + c8), w0b = *(const f32x4*)(cw + c8 + 4);
        const f32x4 w1a = *(const f32x4*)(cw + 1024 + c8), w1b = *(const f32x4*)(cw + 1024 + c8 + 4);
        const f32x4 w2a = *(const f32x4*)(cw + 2048 + c8), w2b = *(const f32x4*)(cw + 2048 + c8 + 4);
        f32x4 oa, ob;
#pragma unroll
        for (int j = 0; j < 2; ++j) {
            oa[2 * j] = bf_lo(bb[j]) * (w0a[2 * j] * bf_lo(x0[j]) + w1a[2 * j] * bf_lo(x1[j]) + w2a[2 * j] * bf_lo(x2[j]));
            oa[2 * j + 1] = bf_hi(bb[j]) * (w0a[2 * j + 1] * bf_hi(x0[j]) + w1a[2 * j + 1] * bf_hi(x1[j]) + w2a[2 * j + 1] * bf_hi(x2[j]));
            ob[2 * j] = bf_lo(bb[2 + j]) * (w0b[2 * j] * bf_lo(x0[2 + j]) + w1b[2 * j] * bf_lo(x1[2 + j]) + w2b[2 * j] * bf_lo(x2[2 + j]));
            ob[2 * j + 1] = bf_hi(bb[2 + j]) * (w0b[2 * j + 1] * bf_hi(x0[2 + j]) + w1b[2 * j + 1] * bf_hi(x1[2 + j]) + w2b[2 * j + 1] * bf_hi(x2[2 + j]));
        }
        *(u32x4*)(uo + (size_t)t * 1024 + c8) = pack8(oa, ob);
    }
}

__device__ __forceinline__ void cmp2_phase(const Params& p) {
    unsigned char* ws = p.ws;
    const bf16_t* pb0 = (const bf16_t*)(ws + WS_O); const bf16_t* pb1 = pb0 + (size_t)16384 * 256; const float* cbias = (const float*)(ws + WS_CBIAS);
    const bf16_t* w2t = (const bf16_t*)(ws + WS_WC2);
    bf16_t* kcmp = (bf16_t*)(ws + WS_KCMP); bf16_t* vcmp = (bf16_t*)(ws + WS_VCMP);
    const int tid = threadIdx.x, lane = tid & 63, wv = tid >> 6, i16 = lane & 15, slab = lane >> 4;
    for (int un = blockIdx.x; un < 256; un += gridDim.x) {
        const int R0 = un * 64, set = R0 >> 13;
        const int rt = wv >> 1;
        const size_t aoff = (size_t)(R0 + 16 * rt + i16) * 256 + 8 * slab;
        u32x4 pw0[8], pw1[8]; f32x4 pba[8], pbb[8];
#pragma unroll
        for (int ks = 0; ks < 8; ++ks) { pw0[ks] = *(const u32x4*)(pb0 + aoff + 32 * ks); pw1[ks] = *(const u32x4*)(pb1 + aoff + 32 * ks);
            pba[ks] = *(const f32x4*)(cbias + set * 256 + 32 * ks + 8 * slab); pbb[ks] = *(const f32x4*)(cbias + set * 256 + 32 * ks + 8 * slab + 4); }
        f32x4 c[2] = {(f32x4){0.f, 0.f, 0.f, 0.f}, (f32x4){0.f, 0.f, 0.f, 0.f}};
        float amax = 0.f;
#pragma unroll
        for (int ks = 0; ks < 8; ++ks) {
            const u32x4 w0 = pw0[ks], w1 = pw1[ks]; const f32x4 ba = pba[ks], bb = pbb[ks];
            f32x4 h0, h1;
            h0[0] = silu_f(bf_lo(w0.x) + bf_lo(w1.x) + ba[0]); h0[1] = silu_f(bf_hi(w0.x) + bf_hi(w1.x) + ba[1]);
            h0[2] = silu_f(bf_lo(w0.y) + bf_lo(w1.y) + ba[2]); h0[3] = silu_f(bf_hi(w0.y) + bf_hi(w1.y) + ba[3]);
            h1[0] = silu_f(bf_lo(w0.z) + bf_lo(w1.z) + bb[0]); h1[1] = silu_f(bf_hi(w0.z) + bf_hi(w1.z) + bb[1]);
            h1[2] = silu_f(bf_lo(w0.w) + bf_lo(w1.w) + bb[2]); h1[3] = silu_f(bf_hi(w0.w) + bf_hi(w1.w) + bb[3]);
            const u32x4 aw = pack8(h0, h1);
            const bf16x8 a = *(const bf16x8*)&aw;
#pragma unroll
            for (int cc = 0; cc < 2; ++cc) {
                const int ct = (wv & 1) * 2 + cc;
                const bf16x8 b = *(const bf16x8*)(w2t + (size_t)set * 64 * 256 + (size_t)(16 * ct + i16) * 256 + 32 * ks + 8 * slab);
                c[cc] = __builtin_amdgcn_mfma_f32_16x16x32_bf16(a, b, c[cc], 0, 0, 0);
            }
        }
#pragma unroll
        for (int cc = 0; cc < 2; ++cc) {
            const int n = 16 * ((wv & 1) * 2 + cc) + i16;
#pragma unroll
            for (int r = 0; r < 4; ++r) {
                const int R = R0 + 16 * rt + 4 * slab + r, rr = R & 8191, bgi = rr >> 9, nn = rr & 511;
                const float v = (nn == 511) ? 0.f : c[cc][r];
                const bf16_t hv = f2bf_sw(v);
                if (set == 0) kcmp[((size_t)bgi * 512 + nn) * 64 + n] = hv;
                else vcmp[(((size_t)bgi * 8 + (nn >> 6)) * 64 + n) * 64 + (nn & 63)] = hv;
                amax = fmaxf(amax, fabsf(v));
            }
        }
        if (set == 0) {
#pragma unroll
            for (int o = 1; o < 64; o <<= 1) amax = fmaxf(amax, __shfl_xor(amax, o));
            if (lane == 0) __hip_atomic_fetch_max((unsigned*)(ws + WS_KMAX) + ((R0 & 8191) >> 9), __float_as_uint(amax), __ATOMIC_RELAXED, __HIP_MEMORY_SCOPE_AGENT);
        }
    }
}

constexpr int KP = 72;
constexpr int IMP_P = 132;
constexpr int A_K = 0, A_V = 24576, A_IMP = 49152, A_WUN = A_IMP + 64 * IMP_P * 4, A_TL = A_WUN + 128, A_SEL = A_TL + 512, A_OFIN = 86016;

template <bool MASK, int KIND>
__device__ __forceinline__ void attn_tile(const LAS bf16_t* Kb, const LAS bf16_t* Vb, const bf16x8 (&qf)[2][2], f32x4 (&O)[2][4], float (&m)[2], float (&l)[2],
                                          const float (&lb)[2], const float (&slope2)[2], const float skmul, int lo, int hi, int col, int slab, LAS float* imp_row, int jbase) {
    const int sw = (col >> 1) & 7;
    constexpr float LAZY_THR = 12.0f;
    f32x4 sc[2][4];
    float mref[2];
#pragma unroll
    for (int ct = 0; ct < 2; ++ct) {
        const float skv = slope2[ct] * skmul;
        mref[ct] = (m[ct] < -1e19f) ? 0.f : m[ct];
        const float lbr = lb[ct] - mref[ct];
#pragma unroll
        for (int st = 0; st < 4; ++st) { const float c0 = fmaf(skv, (float)(16 * st), lbr); sc[ct][st] = (f32x4){c0, c0 + skv, fmaf(skv, 2.f, c0), fmaf(skv, 3.f, c0)}; }
    }
#pragma unroll
    for (int st = 0; st < 4; ++st) {
#pragma unroll
        for (int ks = 0; ks < 2; ++ks) {
            const bf16x8 kf = *(const LAS bf16x8*)(Kb + (16 * st + col) * 64 + (((4 * ks + slab) ^ sw) << 3));
#pragma unroll
            for (int ct = 0; ct < 2; ++ct) sc[ct][st] = __builtin_amdgcn_mfma_f32_16x16x32_bf16(kf, qf[ct][ks], sc[ct][st], 0, 0, 0);
        }
        asm volatile("" ::: "memory");
    }
    if (MASK) {
        const int lo2 = lo - 4 * slab, hi2 = hi - 4 * slab;
#pragma unroll
        for (int ct = 0; ct < 2; ++ct)
#pragma unroll
            for (int st = 0; st < 4; ++st)
#pragma unroll
                for (int r = 0; r < 4; ++r) { const int kk = 16 * st + r; sc[ct][st][r] = (kk >= lo2 && kk <= hi2) ? sc[ct][st][r] : -1e30f; }
    }
    if (KIND != 2) {
        float mxl[2];
#pragma unroll
        for (int ct = 0; ct < 2; ++ct) {
            float mx = -1e30f;
#pragma unroll
            for (int st = 0; st < 4; ++st) mx = fmaxf(fmaxf(mx, fmaxf(sc[ct][st][0], sc[ct][st][1])), fmaxf(sc[ct][st][2], sc[ct][st][3]));
            mxl[ct] = mx;
        }
        const bool slow = __any((mxl[0] > LAZY_THR) || (mxl[1] > LAZY_THR) || (m[0] < -1e19f) || (m[1] < -1e19f));
        if (slow) {
#pragma unroll
            for (int ct = 0; ct < 2; ++ct) {
                const float mx = xmax_16_32(mxl[ct]);
                const float mrel = m[ct] - mref[ct];
                const float mn = fmaxf(mrel, mx);
                const float alpha = __builtin_amdgcn_exp2f(mrel - mn);
                m[ct] = mref[ct] + mn; l[ct] *= alpha;
#pragma unroll
                for (int st = 0; st < 4; ++st) sc[ct][st] = sc[ct][st] - mn;
                if (KIND == 0) {
#pragma unroll
                    for (int dt = 0; dt < 4; ++dt) O[ct][dt] = O[ct][dt] * alpha;
                }
            }
        }
    }
#pragma unroll
    for (int ct = 0; ct < 2; ++ct) {
        f32x4 sum4 = (f32x4){0.f, 0.f, 0.f, 0.f};
#pragma unroll
        for (int st = 0; st < 4; ++st) {
            f32x4 e;
#pragma unroll
            for (int r = 0; r < 4; ++r) e[r] = __builtin_amdgcn_exp2f(sc[ct][st][r]);
            if (KIND == 2) e = e * l[ct];
            sc[ct][st] = e; sum4 += e;
        }
        if (KIND != 2) l[ct] += (sum4[0] + sum4[1]) + (sum4[2] + sum4[3]);
    }
    if (KIND == 1) return;
    if (KIND == 2) {
#pragma unroll
        for (int st = 0; st < 4; ++st) {
            float g4 = (sc[0][st][0] + sc[0][st][1]) + (sc[0][st][2] + sc[0][st][3]) + (sc[1][st][0] + sc[1][st][1]) + (sc[1][st][2] + sc[1][st][3]);
            g4 += __shfl_xor(g4, 8);
            if ((col & 8) == 0) imp_row[jbase + 4 * st + slab] += g4;
        }
        asm volatile("s_waitcnt lgkmcnt(0)" ::: "memory");
#pragma unroll
        for (int st = 0; st < 4; ++st) {
            float la = sc[0][st][3] + sc[1][st][3];
            la += __shfl_xor(la, 8);
            if ((col & 8) == 0) imp_row[jbase + 4 * st + slab + 1] += la;
        }
    }
#pragma unroll
    for (int ks2 = 0; ks2 < 2; ++ks2) {
        bf16x8 pf[2];
#pragma unroll
        for (int ct = 0; ct < 2; ++ct) { const u32x4 w = pack8(sc[ct][2 * ks2], sc[ct][2 * ks2 + 1]); pf[ct] = *(const bf16x8*)&w; }
#pragma unroll
        for (int dt = 0; dt < 4; ++dt) {
            const LAS bf16_t* vrow = Vb + (16 * dt + col) * 64 + 4 * (slab & 1);
            const int vc = (4 * ks2 + (slab >> 1)) ^ sw;
            const u32x2 a0 = *(const LAS u32x2*)(vrow + (vc << 3)), a1 = *(const LAS u32x2*)(vrow + ((vc ^ 2) << 3));
            const u32x4 aw = (u32x4){a0.x, a0.y, a1.x, a1.y};
            const bf16x8 vf = *(const bf16x8*)&aw;
#pragma unroll
            for (int ct = 0; ct < 2; ++ct) O[ct][dt] = __builtin_amdgcn_mfma_f32_16x16x32_bf16(vf, pf[ct], O[ct][dt], 0, 0, 0);
            asm volatile("" ::: "memory");
        }
    }
}

__device__ __forceinline__ int sum_jg(int x) {
    x += __builtin_amdgcn_update_dpp(0, x, 0x128, 0xf, 0xf, false);
    auto a = __builtin_amdgcn_permlane16_swap((unsigned)x, (unsigned)x, false, false);
    x = (int)(a[0] + a[1]);
    auto b = __builtin_amdgcn_permlane32_swap((unsigned)x, (unsigned)x, false, false);
    return (int)(b[0] + b[1]);
}
__device__ __forceinline__ unsigned pick4(const unsigned (&a)[4], int i) { return i == 0 ? a[0] : (i == 1 ? a[1] : (i == 2 ? a[2] : a[3])); }
__device__ __forceinline__ void attn_phase(const Params& p, LAS unsigned char* lds) {
    unsigned char* ws = p.ws;
    const bf16_t* qbuf = (const bf16_t*)(ws + WS_Q); const float* gates = (const float*)(ws + WS_GATES);
    const bf16_t* kcmp = (const bf16_t*)(ws + WS_KCMP); const bf16_t* vcmp = (const bf16_t*)(ws + WS_VCMP);
    const bf16_t* kslc = (const bf16_t*)(ws + WS_KSLC); const bf16_t* vslc = (const bf16_t*)(ws + WS_VSLC);
    const bf16_t* kwin = (const bf16_t*)(ws + WS_KWIN); const bf16_t* vwin = (const bf16_t*)(ws + WS_VWIN);
    bf16_t* obuf = (bf16_t*)(ws + WS_O);
    const int tid = threadIdx.x, lane = tid & 63, w = __builtin_amdgcn_readfirstlane(tid >> 6), col = lane & 15, slab = lane >> 4, qi = lane & 7;
    LAS bf16_t* Ksm = (LAS bf16_t*)(lds + A_K); LAS bf16_t* Vsm = (LAS bf16_t*)(lds + A_V);
    LAS float* imp = (LAS float*)(lds + A_IMP); LAS unsigned* wun = (LAS unsigned*)(lds + A_WUN); LAS unsigned short* tl = (LAS unsigned short*)(lds + A_TL);
    LAS float* imp_row = imp + (8 * w + qi) * IMP_P;
    LAS unsigned* selw = (LAS unsigned*)(lds + A_SEL) + (8 * w + qi) * 4;
    const int dsrc = (tid >> 3) * 64 + ((((tid & 7) ^ ((tid >> 4) & 7))) << 3);
#define ATT_DMA(kptr, vptr, buf) do { \
        __builtin_amdgcn_global_load_lds((const unsigned*)((kptr) + dsrc), (LAS unsigned*)(lds + A_K + (buf) * 8192 + w * 1024), 16, 0, 0); \
        __builtin_amdgcn_global_load_lds((const unsigned*)((vptr) + dsrc), (LAS unsigned*)(lds + A_V + (buf) * 8192 + w * 1024), 16, 0, 0); } while (0)
#define ATT_WAIT(more) do { if (more) asm volatile("s_waitcnt vmcnt(2)" ::: "memory"); else asm volatile("s_waitcnt vmcnt(0)" ::: "memory"); \
        __builtin_amdgcn_s_barrier(); asm volatile("" ::: "memory"); } while (0)

    unsigned* qctr = (unsigned*)(ws + WS_KMAX) + 16;
    LAS int* qslot = (LAS int*)(lds + A_TL + 448);
    if (tid == 0) qslot[0] = (int)__hip_atomic_fetch_add(qctr, 1u, __ATOMIC_RELAXED, __HIP_MEMORY_SCOPE_AGENT);
    __syncthreads();
    int ui = __builtin_amdgcn_readfirstlane(qslot[0]);
    while (ui < 2048) {
        int nxt_ui = 0;
        const int qb = 127 - (ui >> 4), bgi = ui & 15, b = bgi >> 2, g = bgi & 3;
        const int ql = 8 * w + qi, t = qb * 64 + ql;
        const int tok = b * SEQ + t;
        bf16x8 qf[2][2]; float slope2[2]; int hh[2];
#pragma unroll
        for (int ct = 0; ct < 2; ++ct) {
            hh[ct] = 4 * g + 2 * ct + (col >> 3);
            slope2[ct] = exp2f(-0.5f * (float)(hh[ct] + 1)) * LOG2E;
#pragma unroll
            for (int ks = 0; ks < 2; ++ks) qf[ct][ks] = *(const bf16x8*)(qbuf + (size_t)tok * 1024 + hh[ct] * 64 + 32 * ks + 8 * slab);
        }
        for (int i = lane; i < 8 * IMP_P; i += 64) imp[8 * w * IMP_P + i] = 0.f;
        f32x4 O[2][4]; float m[2], l[2];
        LAS f32x4* ofin = (LAS f32x4*)(lds + A_OFIN) + tid;
#pragma unroll
        for (int ct = 0; ct < 2; ++ct) { m[ct] = -1e20f; l[ct] = 0.f;
#pragma unroll
            for (int dt = 0; dt < 4; ++dt) O[ct][dt] = (f32x4){0.f, 0.f, 0.f, 0.f}; }
        float lb[2]; float skmul;
        const int nkt = (4 * qb + 3 + 63) >> 6;
        const int nmax = (t - 31) >> 4;
        int nproc;
        {
            const float kinf = __uint_as_float(((const unsigned*)(ws + WS_KMAX))[bgi]) * 1.01f;
            int kneed = nkt - 1;
#pragma unroll
            for (int ct = 0; ct < 2; ++ct) {
                float qn = 0.f;
#pragma unroll
                for (int ks = 0; ks < 2; ++ks)
#pragma unroll
                    for (int e = 0; e < 8; ++e) qn += __uint_as_float(((unsigned)(unsigned short)qf[ct][ks][e] & 0x7fffu) << 16);
                qn = xsum_16_32(qn) * 1.001f;
                const float X = ((float)t - 1055.f - (170.f + 2.f * qn * kinf) / slope2[ct]) * (1.0f / 1024.0f);
                const int kn = X > 0.f ? (int)ceilf(X) : 0;
                kneed = kn < kneed ? kn : kneed;
            }
#pragma unroll
            for (int o = 1; o < 16; o <<= 1) { const int other = __shfl_xor(kneed, o); kneed = other < kneed ? other : kneed; }
            LAS int* knw = (LAS int*)(lds + A_TL + 384);
            if (lane == 0) knw[w] = kneed;
            __syncthreads();
            int ktmin = knw[0];
#pragma unroll
            for (int w2 = 1; w2 < 8; ++w2) { const int v = knw[w2]; ktmin = v < ktmin ? v : ktmin; }
            nproc = nkt - __builtin_amdgcn_readfirstlane(ktmin);
        }
        const int n1 = 2 * nproc;
        const bf16_t* kc0 = kcmp + (size_t)bgi * 512 * 64; const bf16_t* vc0 = vcmp + (size_t)bgi * 8 * 4096;
#define KT1(i) (nkt - 1 - (((i) < nproc) ? (i) : (i) - nproc))
        asm volatile("" :: "v"(qf[0][0]), "v"(qf[0][1]), "v"(qf[1][0]), "v"(qf[1][1]));
        if (tid == 0) nxt_ui = (int)atomicInc(qctr, 0xffffffffu);
        ATT_DMA(kc0 + KT1(0) * 4096, vc0 + KT1(0) * 4096, 0);
        ATT_DMA(kc0 + KT1(1) * 4096, vc0 + KT1(1) * 4096, 1);
        skmul = 16.f;
        const int nmax_min = (qb * 64 + 8 * w - 31) >> 4;
        int cb = 0;
        for (int i = 0; i < n1; ++i) {
            ATT_WAIT(i + 1 < n1);
            if (i + 2 < n1) { const int nb = cb == 0 ? 2 : cb - 1; ATT_DMA(kc0 + KT1(i + 2) * 4096, vc0 + KT1(i + 2) * 4096, nb); }
            const LAS bf16_t* Kb = Ksm + cb * 4096; const LAS bf16_t* Vb = Vsm + cb * 4096;
            cb = cb == 2 ? 0 : cb + 1;
            const int kt = KT1(i);
#pragma unroll
            for (int ct = 0; ct < 2; ++ct) lb[ct] = slope2[ct] * (16.f * (float)(64 * kt + 4 * slab) + 15.5f - (float)t);
            const int hi = nmax - 64 * kt;
            const bool cmask = (64 * kt + 63 > nmax_min);
            if (i < nproc) { if (cmask) attn_tile<true, 1>(Kb, Vb, qf, O, m, l, lb, slope2, skmul, 0, hi, col, slab, imp_row, 0);
                           else attn_tile<false, 1>(Kb, Vb, qf, O, m, l, lb, slope2, skmul, 0, 63, col, slab, imp_row, 0); }
            else {
                if (i == nproc) {
#pragma unroll
                    for (int ct = 0; ct < 2; ++ct) { float lt = xsum_16_32(l[ct]); l[ct] = lt > 0.f ? fast_rcp(lt) : 0.f; }
                }
                if (cmask) attn_tile<true, 2>(Kb, Vb, qf, O, m, l, lb, slope2, skmul, 0, hi, col, slab, imp_row, 16 * kt);
                else attn_tile<false, 2>(Kb, Vb, qf, O, m, l, lb, slope2, skmul, 0, 63, col, slab, imp_row, 16 * kt);
            }
        }
        {
#pragma unroll
            for (int ct = 0; ct < 2; ++ct) { const float g0 = gates[(size_t)tok * 48 + hh[ct] * 3 + 0];
#pragma unroll
                for (int dt = 0; dt < 4; ++dt) { ofin[(ct * 4 + dt) * 512] = O[ct][dt] * g0; O[ct][dt] = (f32x4){0.f, 0.f, 0.f, 0.f}; }
                m[ct] = -1e20f; l[ct] = 0.f; }
        }
        unsigned sel[4];
        {
            const int jg = lane >> 3;
            unsigned m16 = 0;
            if (qb - 2 <= 13) {
#pragma unroll
                for (int e = 0; e < 16; ++e) if (16 * jg + e <= qb) m16 |= 1u << e;
            } else {
                unsigned key[16];
#pragma unroll
                for (int e = 0; e < 16; ++e) { const int j = 16 * jg + e; const float v = imp_row[j]; key[e] = (j >= 1 && j <= qb - 2) ? (__float_as_uint(v) + 1u) : 0u; }
                unsigned Tt = 0;
                for (int bit = 30; bit >= 0; --bit) {
                    const unsigned cand = Tt | (1u << bit); int cnt = 0;
#pragma unroll
                    for (int e = 0; e < 16; ++e) cnt += (key[e] >= cand) ? 1 : 0;
                    cnt = sum_jg(cnt);
                    if (cnt >= 13) Tt = cand;
                }
                int cgt = 0, ceq = 0;
#pragma unroll
                for (int e = 0; e < 16; ++e) { cgt += (key[e] > Tt) ? 1 : 0; ceq += (key[e] == Tt) ? 1 : 0; }
                cgt = sum_jg(cgt);
                const int need = 13 - cgt;
                int run = 0;
#pragma unroll
                for (int j2 = 0; j2 < 8; ++j2) { const int c = __shfl(ceq, qi + 8 * j2); if (j2 < jg) run += c; }
#pragma unroll
                for (int e = 0; e < 16; ++e) {
                    if (key[e] > Tt) m16 |= 1u << e;
                    else if (key[e] == Tt) { if (run < need) m16 |= 1u << e; ++run; }
                }
#pragma unroll
                for (int e = 0; e < 16; ++e) { const int j = 16 * jg + e; if (j == 0 || j == qb || j == qb - 1) m16 |= 1u << e; }
            }
            sel[0] = sel[1] = sel[2] = sel[3] = 0u;
#pragma unroll
            for (int j2 = 0; j2 < 8; ++j2) { const unsigned v = (unsigned)__shfl((int)m16, qi + 8 * j2); sel[j2 >> 1] |= v << (16 * (j2 & 1)); }
        }
        if (lane < 8) {
#pragma unroll
            for (int k4 = 0; k4 < 4; ++k4) selw[k4] = sel[k4];
        }
        unsigned wu[4];
#pragma unroll
        for (int k4 = 0; k4 < 4; ++k4) { unsigned x = sel[k4]; x |= (unsigned)__shfl_xor((int)x, 1); x |= (unsigned)__shfl_xor((int)x, 2); x |= (unsigned)__shfl_xor((int)x, 4); wu[k4] = (unsigned)__builtin_amdgcn_readfirstlane((int)x); if (lane == 0) wun[w * 4 + k4] = x; }
        __syncthreads();
        unsigned un[4] = {0u, 0u, 0u, 0u};
#pragma unroll
        for (int w2 = 0; w2 < 8; ++w2)
#pragma unroll
            for (int k4 = 0; k4 < 4; ++k4) un[k4] |= wun[w2 * 4 + k4];
#pragma unroll
        for (int k4 = 0; k4 < 4; ++k4) un[k4] = (unsigned)__builtin_amdgcn_readfirstlane((int)un[k4]);
        const int nslc = __popc(un[0]) + __popc(un[1]) + __popc(un[2]) + __popc(un[3]);
        const int jw0 = qb >= 8 ? qb - 8 : 0, nwin = qb - jw0 + 1, n2 = nslc + nwin;
        int tidl = tid; asm volatile("" : "+v"(tidl));
        if (tidl < 128) {
            const int j = tidl, wd = j >> 5, bi = j & 31;
            const unsigned uw = pick4(un, wd);
            if ((uw >> bi) & 1u) {
                int pos = __popc(uw & ((1u << bi) - 1u));
#pragma unroll
                for (int k4 = 0; k4 < 4; ++k4) if (k4 < wd) pos += __popc(un[k4]);
                tl[nslc - 1 - pos] = (unsigned short)j;
            }
        } else if (tidl < 128 + nwin) tl[nslc + (tidl - 128)] = (unsigned short)(0x100 | (qb - (tidl - 128)));
        __syncthreads();
        {
            skmul = 1.f;
#define ATT_DMA2(idx, buf) do { const int _e = tl[idx]; const int _j = _e & 0xff; const bool _w = _e >> 8; \
                ATT_DMA((_w ? kwin : kslc) + ((size_t)bgi * SEQ + 64 * _j) * 64, (_w ? vwin : vslc) + ((size_t)bgi * 128 + _j) * 4096, buf); } while (0)
            ATT_DMA2(0, 0);
            ATT_DMA2(1, 1);
            int cb = 0;
            for (int i = 0; i < n2; ++i) {
                ATT_WAIT(i + 1 < n2);
                if (i + 2 < n2) { const int nb = cb == 0 ? 2 : cb - 1; ATT_DMA2(i + 2, nb); }
                const int buf3 = cb; cb = cb == 2 ? 0 : cb + 1;
                const int e = tl[i];
                const int j = e & 0xff; const bool isw = e >> 8;
#pragma unroll
                for (int ct = 0; ct < 2; ++ct) lb[ct] = slope2[ct] * ((float)(64 * j + 4 * slab) - (float)t);
                const LAS bf16_t* Kb = Ksm + buf3 * 4096; const LAS bf16_t* Vb = Vsm + buf3 * 4096;
                if (isw && i == nslc) {
#pragma unroll
                    for (int ct = 0; ct < 2; ++ct) { float lt = xsum_16_32(l[ct]);
                        const float sc1 = (lt > 0.f ? fast_rcp(lt) : 0.f) * gates[(size_t)tok * 48 + hh[ct] * 3 + 1];
#pragma unroll
                        for (int dt = 0; dt < 4; ++dt) { ofin[(ct * 4 + dt) * 512] += O[ct][dt] * sc1; O[ct][dt] = (f32x4){0.f, 0.f, 0.f, 0.f}; }
                        m[ct] = -1e20f; l[ct] = 0.f; }
                }
                int tlo = 0, thi = 63; bool active = true, domask = false;
                if (!isw) {
                    active = (pick4(wu, j >> 5) >> (j & 31)) & 1u;
                    const bool cval = (selw[j >> 5] >> (j & 31)) & 1u;
                    thi = cval ? (j == qb ? ql : 63) : -1;
                    domask = (j == qb) || !__all(cval);
                } else {
                    if (j == qb) { thi = ql; domask = true; }
                    else if (j == qb - 8) { tlo = ql + 1; domask = true; }
                }
                if (active) {
                    if (domask) attn_tile<true, 0>(Kb, Vb, qf, O, m, l, lb, slope2, skmul, tlo, thi, col, slab, imp_row, 0);
                    else attn_tile<false, 0>(Kb, Vb, qf, O, m, l, lb, slope2, skmul, 0, 63, col, slab, imp_row, 0);
                }
            }
        }
#pragma unroll
        for (int ct = 0; ct < 2; ++ct) { float lt = xsum_16_32(l[ct]);
            const float sc2 = (lt > 0.f ? fast_rcp(lt) : 0.f) * gates[(size_t)tok * 48 + hh[ct] * 3 + 2];
#pragma unroll
            for (int dt = 0; dt < 4; ++dt) {
                const f32x4 o = ofin[(ct * 4 + dt) * 512] + O[ct][dt] * sc2;
                u32x2 wv2; wv2.x = cvt_pk_bf16(o[0], o[1]); wv2.y = cvt_pk_bf16(o[2], o[3]);
                *(u32x2*)(obuf + (size_t)tok * 1024 + hh[ct] * 64 + 16 * dt + 4 * slab) = wv2;
            } }
        if (tid == 0) qslot[0] = nxt_ui;
        __syncthreads();
        ui = __builtin_amdgcn_readfirstlane(qslot[0]);
    }
}

__device__ __forceinline__ void final_phase(const Params& p) {
    float* out = p.out; const bf16_t* hb = (const bf16_t*)(p.ws + WS_HB); const float* part = (const float*)(p.ws + WS_PART) + (size_t)4 * T * 16; const float* gn = p.in[19];
    const int lane = threadIdx.x & 63, wv = threadIdx.x >> 6;
    for (int r = blockIdx.x * 8 + wv; r < T; r += gridDim.x * 8) {
        const float rs = row_rstd(part, r);
#pragma unroll
        for (int j = 0; j < 2; ++j) {
            const u32x4 w = *(const u32x4*)(hb + (size_t)r * 1024 + j * 512 + lane * 8);
            const f32x4 g0 = *(const f32x4*)(gn + j * 512 + lane * 8), g1 = *(const f32x4*)(gn + j * 512 + lane * 8 + 4);
            f32x4* o = (f32x4*)(out + (size_t)r * 1024 + j * 512 + lane * 8);
            o[0] = (f32x4){bf_lo(w.x), bf_hi(w.x), bf_lo(w.y), bf_hi(w.y)} * rs * g0;
            o[1] = (f32x4){bf_lo(w.z), bf_hi(w.z), bf_lo(w.w), bf_hi(w.w)} * rs * g1;
        }
    }
}

#define XB_TMO      128
#define XB_XCNT(j)  (256  + 64 * (j))
#define XB_XSUB(j)  (1280 + 64 * (j))
#define XB_XGEN(j)  (2304 + 64 * (j))
#define XB_TOP      3328
#define XB_TOPGEN   3392
#define XCD_BAR_WORDS 3456
#define XB_SPIN_CAP (1u << 18)
__device__ __forceinline__ unsigned xb_ld(unsigned* p)              { return __hip_atomic_load(p, __ATOMIC_RELAXED, __HIP_MEMORY_SCOPE_AGENT); }
__device__ __forceinline__ unsigned xb_add(unsigned* p, unsigned v) { return __hip_atomic_fetch_add(p, v, __ATOMIC_RELAXED, __HIP_MEMORY_SCOPE_AGENT); }
__device__ __forceinline__ unsigned xb_xcc_id() { return (unsigned)__builtin_amdgcn_s_getreg((3 << 11) | 20) & 0xFu; }
#define XB_SPIN(cond, bar) do { unsigned _sp = 0; while (cond) { __builtin_amdgcn_s_sleep(1); \
    if ((++_sp & 255u) == 0u) { if (xb_ld(&(bar)[XB_TMO])) break; if (_sp > XB_SPIN_CAP) { atomicAdd(&(bar)[XB_TMO], 1u); break; } } } } while (0)
struct XcdBarrier { unsigned* bar; unsigned x; volatile LAS unsigned* st; };
__device__ __forceinline__ XcdBarrier xcd_barrier_post(unsigned* bar, volatile LAS unsigned* st) {
    XcdBarrier b; b.bar = bar; b.x = xb_xcc_id(); b.st = st;
    if (threadIdx.x == 0) (void)xb_add(&bar[XB_XCNT(b.x)], 1u);
    return b;
}
__device__ __forceinline__ void xcd_barrier_complete(unsigned* bar, unsigned x, unsigned& nloc, unsigned& nx) {
    const unsigned G = gridDim.x * gridDim.y * gridDim.z;
    unsigned sum, cnt, mine, sp = 0u;
    for (;;) {
        sum = 0u; cnt = 0u; mine = 0u;
#pragma unroll
        for (unsigned j = 0; j < 16; ++j) { const unsigned c = xb_ld(&bar[XB_XCNT(j)]); sum += c; cnt += (c > 0u) ? 1u : 0u; mine = (j == x) ? c : mine; }
        if (sum == G) break;
        __builtin_amdgcn_s_sleep(1);
        if ((++sp & 255u) == 0u) { if (xb_ld(&bar[XB_TMO])) break; if (sp > XB_SPIN_CAP) { atomicAdd(&bar[XB_TMO], 1u); break; } }
    }
    nloc = mine > 0u ? mine : 1u; nx = cnt > 0u ? cnt : 1u;
}
__device__ __forceinline__ void xcd_barrier(const XcdBarrier& b) {
    asm volatile("s_waitcnt vmcnt(0)" ::: "memory");
    __syncthreads();
    if (threadIdx.x == 0) {
        unsigned* bar = b.bar;
        __builtin_amdgcn_s_waitcnt(0);
        unsigned nloc = b.st[0], nx = b.st[1];
        if (nloc == 0u) { xcd_barrier_complete(bar, b.x, nloc, nx); b.st[0] = nloc; b.st[1] = nx; }
        const unsigned old = xb_add(&bar[XB_XSUB(b.x)], 1u);
        const unsigned gen = old / nloc;
        if (old + 1u == (gen + 1u) * nloc) {
            __builtin_amdgcn_fence(__ATOMIC_RELEASE, "agent");
            asm volatile("s_waitcnt vmcnt(0)" ::: "memory");
            const unsigned og = xb_add(&bar[XB_TOP], 1u);
            const unsigned tg = og / nx;
            if (og + 1u == (tg + 1u) * nx) xb_add(&bar[XB_TOPGEN], 1u);
            else XB_SPIN(xb_ld(&bar[XB_TOPGEN]) == tg, bar);
            __builtin_amdgcn_fence(__ATOMIC_ACQUIRE, "agent");
            xb_add(&bar[XB_XGEN(b.x)], 1u);
            asm volatile("s_waitcnt vmcnt(0)" ::: "memory");
        } else {
            XB_SPIN(xb_ld(&bar[XB_XGEN(b.x)]) == gen, bar);
            __builtin_amdgcn_fence(__ATOMIC_ACQUIRE, "agent");
            asm volatile("s_waitcnt vmcnt(0)" ::: "memory");
        }
    }
    __syncthreads();
}

__global__ void __launch_bounds__(512, 2) fwd_megakernel(Params p) {
    extern __shared__ __attribute__((aligned(16))) unsigned char smem[];
    LAS unsigned char* lds = (LAS unsigned char*)smem;
    cg::grid_group grid = cg::this_grid();
    unsigned char* ws = p.ws;
    float* part = (float*)(ws + WS_PART);
    const int G = gridDim.x, bx = blockIdx.x;
    const int lo = p.ph_lo, hi = p.ph_hi;
#ifndef PH_MASK
#define PH_MASK 0xffff
#endif
#define IN(k) (((PH_MASK >> (k)) & 1) && lo <= (k) && (k) < hi)
    volatile LAS unsigned* xst = (volatile LAS unsigned*)(lds + LDS_BYTES - 16);
    if (threadIdx.x == 0) { xst[0] = 0u; xst[1] = 0u; }
    __syncthreads();
    XcdBarrier xbar; xbar.bar = (unsigned*)(ws + WS_BAR); xbar.x = 0u; xbar.st = xst;
#define SEAM(k) do { if (IN(k) && IN((k) + 1)) { if ((k) == 0) { grid.sync(); xbar = xcd_barrier_post((unsigned*)(ws + WS_BAR), xst); } else xcd_barrier(xbar); } } while (0)
    if (IN(0)) prep_phase(p, lds);
    SEAM(0);
    if (IN(1)) { pg8::Gemm g{(const bf16_t*)(ws + WS_HB), (const bf16_t*)(ws + WS_WIN), 1024, 1024}; pg8::StaticOrder S; S.init(T, 3072, G, bx);
        EpiWin E{part, (bf16_t*)(ws + WS_CV), (bf16_t*)(ws + WS_BG)}; pg8::gemm_phase(lds, g, S, E); }
    SEAM(1);
    if (IN(2)) conv_phase(p);
    SEAM(2);
    if (IN(3)) { pg8::Gemm g{(const bf16_t*)(ws + WS_U), (const bf16_t*)(ws + WS_WOUT), 1024, 1024}; pg8::StaticOrder S; S.init(T, 1024, G, bx);
        EpiResB E{(bf16_t*)(ws + WS_HB), part + (size_t)1 * T * 16}; pg8::gemm_phase(lds, g, S, E); }
    SEAM(3);
    if (IN(4)) { pg8::Gemm g{(const bf16_t*)(ws + WS_HB), (const bf16_t*)(ws + WS_WGU0), 1024, 1024}; pg8::StaticOrder S; S.init(T, 5632, G, bx);
        EpiGu E{part + (size_t)1 * T * 16, (bf16_t*)(ws + WS_HID)}; pg8::gemm_phase(lds, g, S, E); }
    SEAM(4);
    if (IN(5)) { pg8::Gemm g{(const bf16_t*)(ws + WS_HID), (const bf16_t*)(ws + WS_WDN0), FF, FF}; pg8::StaticOrder S; S.init(T, 1024, G, bx);
        EpiResB E{(bf16_t*)(ws + WS_HB), part + (size_t)2 * T * 16}; pg8::gemm_phase(lds, g, S, E); }
    SEAM(5);
    if (IN(6)) { pg8::Gemm g{(const bf16_t*)(ws + WS_HB), (const bf16_t*)(ws + WS_WKVQG), 1024, 1024}; pg8::StaticOrder S; S.init(T, 2560, G, bx);
        EpiKvqg E{part + (size_t)2 * T * 16, ws}; pg8::gemm_phase(lds, g, S, E); }
    SEAM(6);
    if (IN(7)) {
        const bool split = G >= 256;
        if (!split || bx < 128) { pg8::Gemm g{(const bf16_t*)(ws + WS_CMPRAW), (const bf16_t*)(ws + WS_WC1), 1024, 1024}; pg8::CmpOrder S{split ? 128 : G, bx};
            EpiCmp E{(bf16_t*)(ws + WS_O)}; pg8::gemm_phase(lds, g, S, E); }
        if (!split || bx >= 128) { pg8::Gemm g{(const bf16_t*)(ws + WS_HB), (const bf16_t*)(ws + WS_WKVQG), 1024, 1024}; pg8::GateOrder S{split ? G - 128 : G, split ? bx - 128 : bx};
            EpiKvqg E{part + (size_t)2 * T * 16, ws}; pg8::gemm_phase(lds, g, S, E); }
    }
    SEAM(7);
    if (IN(8)) cmp2_phase(p);
    SEAM(8);
    if (IN(9)) attn_phase(p, lds);
    SEAM(9);
    if (IN(10)) { pg8::Gemm g{(const bf16_t*)(ws + WS_O), (const bf16_t*)(ws + WS_WO), 1024, 1024}; pg8::StaticOrder S; S.init(T, 1024, G, bx);
        EpiResB E{(bf16_t*)(ws + WS_HB), part + (size_t)3 * T * 16}; pg8::gemm_phase(lds, g, S, E); }
    SEAM(10);
    if (IN(11)) { pg8::Gemm g{(const bf16_t*)(ws + WS_HB), (const bf16_t*)(ws + WS_WGU1), 1024, 1024}; pg8::StaticOrder S; S.init(T, 5632, G, bx);
        EpiGu E{part + (size_t)3 * T * 16, (bf16_t*)(ws + WS_HID)}; pg8::gemm_phase(lds, g, S, E); }
    SEAM(11);
    if (IN(12)) { pg8::Gemm g{(const bf16_t*)(ws + WS_HID), (const bf16_t*)(ws + WS_WDN1), FF, FF}; pg8::StaticOrder S; S.init(T, 1024, G, bx);
        EpiResB E{(bf16_t*)(ws + WS_HB), part + (size_t)4 * T * 16}; pg8::gemm_phase(lds, g, S, E); }
    SEAM(12);
    if (IN(13)) final_phase(p);
#ifdef DUMP_BASE
    SEAM(13);
    if (lo <= 14 && 14 < hi) {
        const unsigned short* src = (const unsigned short*)(ws + (size_t)(DUMP_BASE));
        const size_t n = (size_t)T * 1024;
        for (size_t i = (size_t)bx * 512 + threadIdx.x; i < n; i += (size_t)G * 512) p.out[i] = (float)src[i] + (float)src[i + n] + (float)src[i + 2 * n];
    }
#endif
}

#ifdef DUMP_BASE
constexpr int N_PHASES = 15;
#else
constexpr int N_PHASES = 14;
#endif
#ifndef N_LAUNCH_SPLIT
#define N_LAUNCH_SPLIT 0
#endif
extern "C" void kernel_launch(void* const* d_in, const int* in_sizes, int n_in, void* d_out, int out_size, void* d_ws, size_t ws_size, hipStream_t stream) {
    static int grid_blocks = 0;
    if (!grid_blocks) {
        int dev = 0, cus = 0, per_cu = 0;
        hipGetDevice(&dev);
        hipDeviceGetAttribute(&cus, hipDeviceAttributeMultiprocessorCount, dev);
        hipFuncSetAttribute((const void*)fwd_megakernel, hipFuncAttributeMaxDynamicSharedMemorySize, LDS_BYTES);
        hipOccupancyMaxActiveBlocksPerMultiprocessor(&per_cu, (const void*)fwd_megakernel, 512, LDS_BYTES);
        if (per_cu < 1) { fprintf(stderr, "occupancy query returned %d\n", per_cu); per_cu = 1; }
        grid_blocks = cus * 1;
    }
    Params p{};
    for (int i = 0; i < 20; ++i) p.in[i] = (const float*)d_in[i];
    p.out = (float*)d_out; p.ws = (unsigned char*)d_ws;
#if N_LAUNCH_SPLIT
    for (int ph = 0; ph < N_PHASES; ++ph) {
        p.ph_lo = ph; p.ph_hi = ph + 1;
        void* args[] = {&p};
        hipError_t e = hipLaunchCooperativeKernel((const void*)fwd_megakernel, dim3(grid_blocks), dim3(512), args, LDS_BYTES, stream);
        if (e != hipSuccess) fprintf(stderr, "cooperative launch failed: %s (grid %d)\n", hipGetErrorString(e), grid_blocks);
    }
#else
    p.ph_lo = 0; p.ph_hi = N_PHASES;
    void* args[] = {&p};
    hipError_t e = hipLaunchCooperativeKernel((const void*)fwd_megakernel, dim3(grid_blocks), dim3(512), args, LDS_BYTES, stream);
    if (e != hipSuccess) fprintf(stderr, "cooperative launch failed: %s (grid %d)\n", hipGetErrorString(e), grid_blocks);
#endif
}
```

```cpp
#include <hip/hip_runtime.h>
#include <hip/hip_cooperative_groups.h>
#include <cstdio>
namespace cg = cooperative_groups;

#define LAS __attribute__((address_space(3)))
typedef unsigned short bf16_t;
typedef short bf16x8 __attribute__((ext_vector_type(8)));
typedef float f32x4 __attribute__((ext_vector_type(4)));
typedef short bf16x4 __attribute__((ext_vector_type(4)));
typedef unsigned u32x4 __attribute__((ext_vector_type(4)));
typedef unsigned u32x2 __attribute__((ext_vector_type(2)));

constexpr int T = 32768, DM = 1024, SEQ = 8192, FF = 2816;
constexpr float LOG2E = 1.4426950408889634f;
constexpr size_t MBY = 1u << 20;
constexpr size_t WS_PART = 0;
constexpr size_t WS_BAR = 10 * MBY + 512 * 1024;
constexpr size_t WS_KMAX = 10 * MBY + 768 * 1024;
constexpr size_t WS_CBIAS = 11 * MBY;
constexpr size_t WS_WIN = 12 * MBY;
constexpr size_t WS_WOUT = 18 * MBY;
constexpr size_t WS_WGU0 = 20 * MBY;
constexpr size_t WS_WGU1 = 31 * MBY;
constexpr size_t WS_WDN0 = 42 * MBY;
constexpr size_t WS_WDN1 = 48 * MBY;
constexpr size_t WS_WKVQG = 54 * MBY;
constexpr size_t WS_WC1 = 60 * MBY;
constexpr size_t WS_WO = 62 * MBY;
constexpr size_t WS_WC2 = 64 * MBY;
constexpr size_t WS_HB = 65 * MBY;
constexpr size_t WS_HRES = 129 * MBY;
constexpr size_t WS_R = 257 * MBY;
constexpr size_t WS_CV = WS_R, WS_BG = WS_R + 64 * MBY, WS_U = WS_R + 128 * MBY;
constexpr size_t WS_HID = WS_R;
constexpr size_t WS_CMPRAW = WS_R;
constexpr size_t WS_KSLC = WS_R + 33 * MBY, WS_VSLC = WS_R + 49 * MBY, WS_KWIN = WS_R + 65 * MBY, WS_VWIN = WS_R + 81 * MBY;
constexpr size_t WS_Q = WS_R + 97 * MBY;
constexpr size_t WS_GATES = WS_R + 161 * MBY;
constexpr size_t WS_CHID = WS_R + 168 * MBY;
constexpr size_t WS_KCMP = WS_R + 176 * MBY;
constexpr size_t WS_VCMP = WS_R + 177 * MBY;
constexpr size_t WS_O = WS_R + 178 * MBY;
constexpr int LDS_BYTES = 155648;

struct Params { const float* in[20]; float* out; unsigned char* ws; int ph_lo, ph_hi; };

typedef float f32x2_t __attribute__((ext_vector_type(2)));
typedef __bf16 bf16x2_t __attribute__((ext_vector_type(2)));
__device__ __forceinline__ unsigned cvt_pk_bf16(float lo, float hi) { const f32x2_t v = {lo, hi}; const bf16x2_t b = __builtin_convertvector(v, bf16x2_t); return __builtin_bit_cast(unsigned, b); }
__device__ __forceinline__ bf16_t f2bf_sw(float f) { return (bf16_t)(cvt_pk_bf16(f, f) & 0xffffu); }
__device__ __forceinline__ float bf_lo(unsigned w) { return __uint_as_float(w << 16); }
__device__ __forceinline__ float bf_hi(unsigned w) { return __uint_as_float(w & 0xffff0000u); }
__device__ __forceinline__ u32x4 pack8(const f32x4 a, const f32x4 b) { u32x4 w; w.x = cvt_pk_bf16(a[0], a[1]); w.y = cvt_pk_bf16(a[2], a[3]); w.z = cvt_pk_bf16(b[0], b[1]); w.w = cvt_pk_bf16(b[2], b[3]); return w; }
__device__ __forceinline__ float row_rstd(const float* part, int r) {
    const f32x4* p = (const f32x4*)(part + (size_t)r * 16);
    const f32x4 s = (p[0] + p[1]) + (p[2] + p[3]);
    return rsqrtf(((s[0] + s[1]) + (s[2] + s[3])) * (1.0f / 1024.0f) + 1e-5f);
}
__device__ __forceinline__ float xsum_16_32(float x) { x += __shfl_xor(x, 16); x += __shfl_xor(x, 32); return x; }
__device__ __forceinline__ float xmax_16_32(float x) { x = fmaxf(x, __shfl_xor(x, 16)); x = fmaxf(x, __shfl_xor(x, 32)); return x; }
__device__ __forceinline__ void rows_rstd(const float* part, int row0, int fq, float (&rs)[2][4]) {
    f32x4 q[2][4];
#pragma unroll
    for (int ai = 0; ai < 2; ++ai)
#pragma unroll
        for (int m = 0; m < 4; ++m) q[ai][m] = ((const f32x4*)(part + (size_t)(row0 + ai * 128 + m * 16) * 16))[fq];
#pragma unroll
    for (int ai = 0; ai < 2; ++ai)
#pragma unroll
        for (int m = 0; m < 4; ++m) {
            float t = (q[ai][m][0] + q[ai][m][1]) + (q[ai][m][2] + q[ai][m][3]);
            t = xsum_16_32(t);
            rs[ai][m] = rsqrtf(t * (1.0f / 1024.0f) + 1e-5f);
        }
}
__device__ __forceinline__ float fast_rcp(float x) { return __builtin_amdgcn_rcpf(x); }
__device__ __forceinline__ float sigmoid_f(float g) { return fast_rcp(1.0f + __builtin_amdgcn_exp2f(g * -LOG2E)); }
__device__ __forceinline__ float silu_f(float g) { return g * sigmoid_f(g); }

namespace pg8 {
constexpr int BM = 256, BK = 64, HALF = 128, HTB = HALF * BK * 2, NXCD = 8, WGM = 8;
__device__ __forceinline__ int lds_byte(int r, int c) { const int st = (r >> 4) * 2 + (c >> 5), rr = r & 15, cc = c & 31, ob = rr * 64 + cc * 2; return st * 1024 + (ob ^ (((ob >> 9) & 1) << 5)); }
__device__ __forceinline__ void stage_rc(int b, int& R, int& C) { const int st = b / 1024, sb = b % 1024, swz = sb ^ (((sb >> 9) & 1) << 5); R = (st >> 1) * 16 + swz / 64; C = (st & 1) * 32 + (swz % 64) / 2; }
__device__ __forceinline__ int perm32(int rho) { const int n = rho >> 4, i = rho & 15; return 8 * (i >> 2) + 4 * n + (i & 3); }
struct Unit { int pm, pn, ar; };
struct Gemm { const bf16_t* A; const bf16_t* Bt; int lda, K; };
struct StaticOrder {
    int nM, nN, nwg, G, c;
    __device__ void init(int M, int N, int G_, int c_) { nM = M / BM; nN = N / BM; nwg = nM * nN; G = G_; c = c_; }
    __device__ bool next(int i, Unit& u) const {
        const long L = (long)i * G + c; if (L >= nwg) return false;
        int wgid = (int)L; { const int q = nwg / NXCD, r = nwg % NXCD, xcd = wgid % NXCD, off = wgid / NXCD; wgid = (xcd < r ? xcd * (q + 1) : r * (q + 1) + (xcd - r) * q) + off; }
        const int nig = WGM * nN, gid = wgid / nig, fm = gid * WGM, gsz = (nM - fm) < WGM ? (nM - fm) : WGM;
        u.pm = fm + ((wgid % nig) % gsz); u.pn = (wgid % nig) / gsz; u.ar = 0; return true;
    }
};
struct CmpOrder {
    int G, c;
    __device__ bool next(int i, Unit& u) const { const int L = i * G + c; if (L >= 128) return false; u.pm = L >> 1; u.ar = L & 1; u.pn = (u.pm >> 5) * 2 + (L & 1); return true; }
};

struct GateOrder {
    int G, c;
    __device__ bool next(int i, Unit& u) const { const int L = i * G + c; if (L >= 128) return false; u.pm = L; u.pn = 10; u.ar = 0; return true; }
};
template <class Epi, class Sched>
__device__ __forceinline__ void gemm_phase(LAS unsigned char* lds, const Gemm g, const Sched& S, const Epi& E) {
    const int tid = threadIdx.x, wid = __builtin_amdgcn_readfirstlane(tid >> 6), lane = tid & 63, wr = wid >> 2, wc = wid & 3, fr = lane & 15, fq = lane >> 4;
    const int K = g.K, nt = K / BK;
    unsigned voffA[2], voffB[2];
#pragma unroll
    for (int i = 0; i < 2; ++i) { int R, C; stage_rc(tid * 16 + i * 8192, R, C); const int Rb = (R & ~31) + perm32(R & 31);
        voffA[i] = (unsigned)(R * g.lda + C) * 2u; voffB[i] = (unsigned)(Rb * K + C) * 2u; }
    const size_t kstep = (size_t)(BK * 2);
    const size_t hstepA = (size_t)HALF * g.lda * 2, hstepB = (size_t)HALF * K * 2;
    const size_t tstepA = 2 * hstepA, tstepB = 2 * hstepB;
    const unsigned ldsw = (unsigned)wid * 1024u;
    const int aoff = lds_byte(wr * 64 + fr, fq * 8), boff = lds_byte(wc * 32 + fr, fq * 8);
#define PG8_SA(b, h) (((b) * 2 + (h)) * HTB)
#define PG8_SB(b, h) ((4 + (b) * 2 + (h)) * HTB)
#define PG8_STAGE(bufoff, gbase, voff) do { _Pragma("unroll") for (int _i = 0; _i < 2; ++_i) \
        __builtin_amdgcn_global_load_lds((const unsigned*)((const char*)(gbase) + (voff)[_i]), (LAS unsigned*)(lds + (bufoff) + ldsw + _i * 8192), 16, 0, 0); } while (0)
#define PG8_LDA(dst, b, h) do { _Pragma("unroll") for (int m = 0; m < 4; ++m) _Pragma("unroll") for (int k = 0; k < 2; ++k) dst[m][k] = *(const LAS bf16x8*)(lds + PG8_SA(b, h) + aoff + m * 2048 + k * 1024); } while (0)
#define PG8_LDB(dst, b, h) do { _Pragma("unroll") for (int n = 0; n < 2; ++n) _Pragma("unroll") for (int k = 0; k < 2; ++k) dst[n][k] = *(const LAS bf16x8*)(lds + PG8_SB(b, h) + boff + n * 2048 + k * 1024); } while (0)
#define PG8_MMA(ai, bj, At, Bt) do { __builtin_amdgcn_s_setprio(1); _Pragma("unroll") for (int m = 0; m < 4; ++m) _Pragma("unroll") for (int n = 0; n < 2; ++n) _Pragma("unroll") for (int k = 0; k < 2; ++k) \
        acc[ai][bj][m][n] = __builtin_amdgcn_mfma_f32_16x16x32_bf16(Bt[n][k], At[m][k], acc[ai][bj][m][n], 0, 0, 0); __builtin_amdgcn_s_setprio(0); } while (0)
#define PG8_WAIT_V(n) asm volatile("s_waitcnt vmcnt(" #n ")" ::: "memory")
#define PG8_WAIT_L(n) asm volatile("s_waitcnt lgkmcnt(" #n ")" ::: "memory")
#define PG8_BAR __builtin_amdgcn_s_barrier()
#define PG8_SCHED __builtin_amdgcn_sched_barrier(0)
    Unit cur, nxt; int ui = 0;
    if (!S.next(0, cur)) return;
    f32x4 acc[2][2][4][2];
#pragma unroll
    for (int a = 0; a < 2; ++a)
#pragma unroll
        for (int b = 0; b < 2; ++b)
#pragma unroll
            for (int m = 0; m < 4; ++m)
#pragma unroll
                for (int n = 0; n < 2; ++n) acc[a][b][m][n] = (f32x4){0.f, 0.f, 0.f, 0.f};
    bf16x8 At[4][2], B0[2][2], B1[2][2];
    const char* cA = (const char*)g.A + (size_t)cur.pm * tstepA + (size_t)cur.ar * g.lda * 2; const char* cB = (const char*)g.Bt + (size_t)cur.pn * tstepB;
    LAS unsigned char* rsimg = lds + 131072 + wr * 8192;
    if constexpr (Epi::NEEDS_RS) E.pre(cur, rsimg, wid, wr, lane);
    PG8_STAGE(PG8_SB(0, 0), cB, voffB); PG8_STAGE(PG8_SA(0, 0), cA, voffA); PG8_STAGE(PG8_SB(0, 1), cB + hstepB, voffB); PG8_STAGE(PG8_SA(0, 1), cA + hstepA, voffA);
    if (wr == 1) PG8_BAR;
    PG8_WAIT_V(4); PG8_BAR;
    PG8_STAGE(PG8_SB(1, 0), cB + kstep, voffB); PG8_STAGE(PG8_SA(1, 0), cA + kstep, voffA); PG8_STAGE(PG8_SB(1, 1), cB + hstepB + kstep, voffB);
    PG8_WAIT_V(6); PG8_BAR;
    for (;;) {
        const bool has_next = S.next(ui + 1, nxt);
        const char* nA = has_next ? (const char*)g.A + (size_t)nxt.pm * tstepA + (size_t)nxt.ar * g.lda * 2 : cA; const char* nB = has_next ? (const char*)g.Bt + (size_t)nxt.pn * tstepB : cB;
        for (int t = 0; t < nt; t += 2) {
            const bool last = (t == nt - 2);
            const char* a1 = cA + (size_t)(t + 1) * kstep;
            const char* a2 = last ? nA : cA + (size_t)(t + 2) * kstep; const char* b2 = last ? nB : cB + (size_t)(t + 2) * kstep;
            const char* a3 = a2 + kstep; const char* b3 = b2 + kstep;
            PG8_LDB(B0, 0, 0); PG8_SCHED; PG8_LDA(At, 0, 0); PG8_STAGE(PG8_SA(1, 1), a1 + hstepA, voffA);
            PG8_WAIT_L(8); PG8_BAR; PG8_WAIT_L(0); PG8_MMA(0, 0, At, B0); PG8_BAR; PG8_SCHED;
            PG8_LDB(B1, 0, 1); PG8_STAGE(PG8_SB(0, 0), b2, voffB);
            PG8_BAR; PG8_WAIT_L(0); PG8_MMA(0, 1, At, B1); PG8_BAR;
            PG8_LDA(At, 0, 1); PG8_STAGE(PG8_SA(0, 0), a2, voffA);
            PG8_BAR; PG8_WAIT_L(0); PG8_MMA(1, 0, At, B0); PG8_BAR; PG8_SCHED;
            PG8_STAGE(PG8_SB(0, 1), b2 + hstepB, voffB);
            PG8_WAIT_V(6); PG8_BAR; PG8_MMA(1, 1, At, B1); PG8_BAR;
            PG8_LDB(B0, 1, 0); PG8_SCHED; PG8_LDA(At, 1, 0); PG8_STAGE(PG8_SA(0, 1), a2 + hstepA, voffA);
            PG8_WAIT_L(8); PG8_BAR; PG8_WAIT_L(0); PG8_MMA(0, 0, At, B0); PG8_BAR; PG8_SCHED;
            PG8_LDB(B1, 1, 1); PG8_STAGE(PG8_SB(1, 0), b3, voffB);
            PG8_BAR; PG8_WAIT_L(0); PG8_MMA(0, 1, At, B1); PG8_BAR;
            PG8_LDA(At, 1, 1); PG8_STAGE(PG8_SA(1, 0), a3, voffA);
            PG8_BAR; PG8_WAIT_L(0); PG8_MMA(1, 0, At, B0); PG8_BAR; PG8_SCHED;
            PG8_STAGE(PG8_SB(1, 1), b3 + hstepB, voffB);
            PG8_WAIT_V(6); PG8_BAR; PG8_MMA(1, 1, At, B1); PG8_BAR;
        }
        if constexpr (Epi::NEEDS_RS) {
            float rsa[2][4];
            {
                f32x4 q[2][4];
#pragma unroll
                for (int ai = 0; ai < 2; ++ai)
#pragma unroll
                    for (int m = 0; m < 4; ++m) q[ai][m] = *(const LAS f32x4*)(rsimg + (ai * 4 + m) * 1024 + fq * 256 + fr * 16);
#pragma unroll
                for (int ai = 0; ai < 2; ++ai)
#pragma unroll
                    for (int m = 0; m < 4; ++m) { const float t4 = xsum_16_32((q[ai][m][0] + q[ai][m][1]) + (q[ai][m][2] + q[ai][m][3])); rsa[ai][m] = rsqrtf(t4 * (1.0f / 1024.0f) + 1e-5f); }
                asm volatile("s_waitcnt lgkmcnt(0)" ::: "memory"); PG8_BAR; asm volatile("" ::: "memory");
                if (has_next) E.pre(nxt, rsimg, wid, wr, lane);
            }
            E(acc, cur, wr, wc, fr, fq, rsa);
        } else E(acc, cur, wr, wc, fr, fq);
        if (!has_next) break;
#pragma unroll
        for (int a = 0; a < 2; ++a)
#pragma unroll
            for (int b = 0; b < 2; ++b)
#pragma unroll
                for (int m = 0; m < 4; ++m)
#pragma unroll
                    for (int n = 0; n < 2; ++n) acc[a][b][m][n] = (f32x4){0.f, 0.f, 0.f, 0.f};
        cur = nxt; cA = nA; cB = nB; ++ui;
    }
    PG8_WAIT_V(0);
    if (wr == 0) PG8_BAR;
    PG8_BAR;
#undef PG8_SA
#undef PG8_SB
#undef PG8_STAGE
#undef PG8_LDA
#undef PG8_LDB
#undef PG8_MMA
#undef PG8_WAIT_V
#undef PG8_WAIT_L
#undef PG8_BAR
#undef PG8_SCHED
}
}
using pg8::Unit;
typedef f32x4 AccT[2][2][4][2];

struct EpiWin {
    const float* part; bf16_t* cv; bf16_t* bg;
        static constexpr bool NEEDS_RS = true;
    __device__ __forceinline__ void pre(const Unit& u, LAS unsigned char* img, int wid, int wr, int lane) const {
#pragma unroll
        for (int k = 0; k < 2; ++k) {
            const int L = k * 4096 + (wid & 3) * 1024 + lane * 16, gq = L >> 10, c = (L >> 8) & 3, rr = (L >> 4) & 15, hl = gq * 16 + rr;
            const int row = u.pm * 256 + (hl >> 6) * 128 + wr * 64 + (hl & 63);
            __builtin_amdgcn_global_load_lds((const unsigned*)(part + (size_t)row * 16 + c * 4), (LAS unsigned*)(img + k * 4096 + (wid & 3) * 1024), 16, 0, 0);
        }
    }
    __device__ __forceinline__ void operator()(const AccT& acc, const Unit& u, int wr, int wc, int fr, int fq, const float (&rsa)[2][4]) const {
        const int row0 = u.pm * 256 + wr * 64 + fr, cbase = wc * 32 + 8 * fq;
#pragma unroll
        for (int ai = 0; ai < 2; ++ai)
#pragma unroll
            for (int m = 0; m < 4; ++m) {
                const int r = row0 + ai * 128 + m * 16; const float rs = rsa[ai][m];
                if (u.pn < 8) { const float rs2 = rs * rs;
                    *(u32x4*)(cv + (size_t)r * 1024 + u.pn * 128 + cbase) = pack8(acc[ai][0][m][0] * acc[ai][1][m][0] * rs2, acc[ai][0][m][1] * acc[ai][1][m][1] * rs2);
                } else {
#pragma unroll
                    for (int bj = 0; bj < 2; ++bj) *(u32x4*)(bg + (size_t)r * 1024 + (u.pn - 8) * 256 + bj * 128 + cbase) = pack8(acc[ai][bj][m][0] * rs, acc[ai][bj][m][1] * rs);
                }
            }
    }
};
struct EpiRes {
    static constexpr bool NEEDS_RS = false;
    const float* resid; float* hout; bf16_t* hb; float* part_out;
    __device__ __forceinline__ void operator()(const AccT& acc, const Unit& u, int wr, int wc, int fr, int fq) const {
        const int row0 = u.pm * 256 + wr * 64 + fr, cbase = wc * 32 + 8 * fq;
#pragma unroll
        for (int ai = 0; ai < 2; ++ai) {
          f32x4 rv[4][2][2];
#pragma unroll
          for (int m = 0; m < 4; ++m)
#pragma unroll
              for (int bj = 0; bj < 2; ++bj) { const size_t off = (size_t)(row0 + ai * 128 + m * 16) * 1024 + u.pn * 256 + bj * 128 + cbase;
                  rv[m][bj][0] = *(const f32x4*)(resid + off); rv[m][bj][1] = *(const f32x4*)(resid + off + 4); }
#pragma unroll
            for (int m = 0; m < 4; ++m) {
                const int r = row0 + ai * 128 + m * 16; float ss = 0.f;
#pragma unroll
                for (int bj = 0; bj < 2; ++bj) {
                    const size_t off = (size_t)r * 1024 + u.pn * 256 + bj * 128 + cbase;
                    const f32x4 v0 = rv[m][bj][0] + acc[ai][bj][m][0], v1 = rv[m][bj][1] + acc[ai][bj][m][1];
                    *(f32x4*)(hout + off) = v0; *(f32x4*)(hout + off + 4) = v1;
                    if (hb) *(u32x4*)(hb + off) = pack8(v0, v1);
                    ss += (v0[0] * v0[0] + v0[1] * v0[1]) + (v0[2] * v0[2] + v0[3] * v0[3]) + (v1[0] * v1[0] + v1[1] * v1[1]) + (v1[2] * v1[2] + v1[3] * v1[3]);
                }
                ss = xsum_16_32(ss);
                if (fq == 0) part_out[(size_t)r * 16 + u.pn * 4 + wc] = ss;
            }
        }
    }
};
struct EpiResB {
    static constexpr bool NEEDS_RS = false;
    bf16_t* hb; float* part_out;
    __device__ __forceinline__ void operator()(const AccT& acc, const Unit& u, int wr, int wc, int fr, int fq) const {
        const int row0 = u.pm * 256 + wr * 64 + fr, cbase = wc * 32 + 8 * fq;
#pragma unroll
        for (int ai = 0; ai < 2; ++ai) {
            u32x4 rv[4][2];
#pragma unroll
            for (int m = 0; m < 4; ++m)
#pragma unroll
                for (int bj = 0; bj < 2; ++bj) rv[m][bj] = *(const u32x4*)(hb + (size_t)(row0 + ai * 128 + m * 16) * 1024 + u.pn * 256 + bj * 128 + cbase);
#pragma unroll
            for (int m = 0; m < 4; ++m) {
                const int r = row0 + ai * 128 + m * 16; float ss = 0.f;
#pragma unroll
                for (int bj = 0; bj < 2; ++bj) {
                    const u32x4 w = rv[m][bj];
                    const f32x4 v0 = (f32x4){bf_lo(w.x), bf_hi(w.x), bf_lo(w.y), bf_hi(w.y)} + acc[ai][bj][m][0];
                    const f32x4 v1 = (f32x4){bf_lo(w.z), bf_hi(w.z), bf_lo(w.w), bf_hi(w.w)} + acc[ai][bj][m][1];
                    *(u32x4*)(hb + (size_t)r * 1024 + u.pn * 256 + bj * 128 + cbase) = pack8(v0, v1);
                    ss += (v0[0] * v0[0] + v0[1] * v0[1]) + (v0[2] * v0[2] + v0[3] * v0[3]) + (v1[0] * v1[0] + v1[1] * v1[1]) + (v1[2] * v1[2] + v1[3] * v1[3]);
                }
                ss = xsum_16_32(ss);
                if (fq == 0) part_out[(size_t)r * 16 + u.pn * 4 + wc] = ss;
            }
        }
    }
};
struct EpiGu {
    const float* part; bf16_t* hid;
        static constexpr bool NEEDS_RS = true;
    __device__ __forceinline__ void pre(const Unit& u, LAS unsigned char* img, int wid, int wr, int lane) const {
#pragma unroll
        for (int k = 0; k < 2; ++k) {
            const int L = k * 4096 + (wid & 3) * 1024 + lane * 16, gq = L >> 10, c = (L >> 8) & 3, rr = (L >> 4) & 15, hl = gq * 16 + rr;
            const int row = u.pm * 256 + (hl >> 6) * 128 + wr * 64 + (hl & 63);
            __builtin_amdgcn_global_load_lds((const unsigned*)(part + (size_t)row * 16 + c * 4), (LAS unsigned*)(img + k * 4096 + (wid & 3) * 1024), 16, 0, 0);
        }
    }
    __device__ __forceinline__ void operator()(const AccT& acc, const Unit& u, int wr, int wc, int fr, int fq, const float (&rsa)[2][4]) const {
        const int row0 = u.pm * 256 + wr * 64 + fr, cbase = wc * 32 + 8 * fq;
#pragma unroll
        for (int ai = 0; ai < 2; ++ai)
#pragma unroll
            for (int m = 0; m < 4; ++m) {
                const int r = row0 + ai * 128 + m * 16; const float rs = rsa[ai][m];
                f32x4 o[2];
#pragma unroll
                for (int n = 0; n < 2; ++n)
#pragma unroll
                    for (int j = 0; j < 4; ++j) { const float gg = acc[ai][0][m][n][j] * rs, uu = acc[ai][1][m][n][j] * rs; o[n][j] = silu_f(gg) * uu; }
                *(u32x4*)(hid + (size_t)r * FF + u.pn * 128 + cbase) = pack8(o[0], o[1]);
            }
    }
};
struct EpiKvqg {
    const float* part; unsigned char* ws;
        static constexpr bool NEEDS_RS = true;
    __device__ __forceinline__ void pre(const Unit& u, LAS unsigned char* img, int wid, int wr, int lane) const {
#pragma unroll
        for (int k = 0; k < 2; ++k) {
            const int L = k * 4096 + (wid & 3) * 1024 + lane * 16, gq = L >> 10, c = (L >> 8) & 3, rr = (L >> 4) & 15, hl = gq * 16 + rr;
            const int row = u.pm * 256 + (hl >> 6) * 128 + wr * 64 + (hl & 63);
            __builtin_amdgcn_global_load_lds((const unsigned*)(part + (size_t)row * 16 + c * 4), (LAS unsigned*)(img + k * 4096 + (wid & 3) * 1024), 16, 0, 0);
        }
    }
    __device__ __forceinline__ void operator()(const AccT& acc, const Unit& u, int wr, int wc, int fr, int fq, const float (&rsa)[2][4]) const {
        const int row0 = u.pm * 256 + wr * 64 + fr, cbase = wc * 32 + 8 * fq;
#pragma unroll
        for (int ai = 0; ai < 2; ++ai)
#pragma unroll
            for (int m = 0; m < 4; ++m) {
                const int r = row0 + ai * 128 + m * 16; const float rs = rsa[ai][m];
                const int b = r >> 13, s = r & 8191;
#pragma unroll
                for (int bj = 0; bj < 2; ++bj) {
                    const int col = bj * 128 + cbase;
                    const f32x4 v0 = acc[ai][bj][m][0] * rs, v1 = acc[ai][bj][m][1] * rs;
                    if (u.pn < 6) {
                        const int gi = col >> 6, d = col & 63, bgi = b * 4 + gi;
                        if (u.pn < 2) { *(u32x4*)((bf16_t*)(ws + WS_CMPRAW) + ((size_t)(u.pn * 16 + bgi) * SEQ + s) * 64 + d) = pack8(v0, v1); }
                        else if (u.pn == 2 || u.pn == 4) { *(u32x4*)((bf16_t*)(ws + (u.pn == 2 ? WS_KSLC : WS_KWIN)) + ((size_t)bgi * SEQ + s) * 64 + d) = pack8(v0, v1); }
                        else { bf16_t* vt = (bf16_t*)(ws + (u.pn == 3 ? WS_VSLC : WS_VWIN)) + ((size_t)(bgi * 128 + (s >> 6)) * 64 + d) * 64 + (s & 63);
                            const u32x4 w = pack8(v0, v1);
                            vt[0 * 64] = (bf16_t)(w.x & 0xffff); vt[1 * 64] = (bf16_t)(w.x >> 16); vt[2 * 64] = (bf16_t)(w.y & 0xffff); vt[3 * 64] = (bf16_t)(w.y >> 16);
                            vt[4 * 64] = (bf16_t)(w.z & 0xffff); vt[5 * 64] = (bf16_t)(w.z >> 16); vt[6 * 64] = (bf16_t)(w.w & 0xffff); vt[7 * 64] = (bf16_t)(w.w >> 16); }
                    } else if (u.pn < 10) {
                        const float qs = 0.125f * LOG2E;
                        *(u32x4*)((bf16_t*)(ws + WS_Q) + (size_t)r * 1024 + (u.pn - 6) * 256 + col) = pack8(v0 * qs, v1 * qs);
                    } else {
                        if (col < 48) { float* gp = (float*)(ws + WS_GATES) + (size_t)r * 48 + col;
                            f32x4 a, c2;
#pragma unroll
                            for (int j = 0; j < 4; ++j) { a[j] = sigmoid_f(v0[j]); c2[j] = sigmoid_f(v1[j]); }
                            *(f32x4*)gp = a; *(f32x4*)(gp + 4) = c2; }
                    }
                }
            }
    }
};
struct EpiCmp {
    static constexpr bool NEEDS_RS = false;
    bf16_t* pbuf;
    __device__ __forceinline__ void operator()(const AccT& acc, const Unit& u, int wr, int wc, int fr, int fq) const {
        const int row0 = u.pm * 256 + wr * 64 + fr, cbase = wc * 32 + 8 * fq;
        bf16_t* base = pbuf + (size_t)(u.pn & 1) * 16384 * 256;
#pragma unroll
        for (int ai = 0; ai < 2; ++ai)
#pragma unroll
            for (int m = 0; m < 4; ++m) {
                const int r = row0 + ai * 128 + m * 16;
#pragma unroll
                for (int bj = 0; bj < 2; ++bj) *(u32x4*)(base + (size_t)r * 256 + bj * 128 + cbase) = pack8(acc[ai][bj][m][0], acc[ai][bj][m][1]);
            }
    }
};

__device__ __forceinline__ void transpose_item(const float* W, int K, int Nsrc, bf16_t* dst, int kind, const float* gain, int item, LAS float* scr, int nN64) {
    const int tid = threadIdx.x;
    const int kb = item / nN64, nb = item % nN64, k0 = kb * 64, nd0 = nb * 64;
    int ns0 = nd0;
    if (kind == 1) { if (nd0 < 2048) { const int pn = nd0 >> 8, half = (nd0 >> 7) & 1, c = nd0 & 127; ns0 = 1024 + half * 1024 + pn * 128 + c; } else ns0 = nd0 - 2048; }
    else if (kind == 2) { const int pn = nd0 >> 8, half = (nd0 >> 7) & 1, c = nd0 & 127; ns0 = half * FF + pn * 128 + c; }
    const int kk = tid >> 4, n4 = (tid & 15) * 4;
#pragma unroll
    for (int i = 0; i < 2; ++i) {
        const int k = k0 + kk + 32 * i;
        f32x4 v = (f32x4){0.f, 0.f, 0.f, 0.f};
        if (ns0 + n4 < Nsrc) v = *(const f32x4*)(W + (size_t)k * Nsrc + ns0 + n4);
        if (gain) v = v * gain[k];
        LAS float* sp = scr + (kk + 32 * i) * 65 + n4;
        sp[0] = v[0]; sp[1] = v[1]; sp[2] = v[2]; sp[3] = v[3];
    }
    __syncthreads();
    const int n = tid >> 3, kc = (tid & 7) * 8;
    const LAS float* s = scr + kc * 65 + n;
    u32x4 o; o.x = cvt_pk_bf16(s[0], s[65]); o.y = cvt_pk_bf16(s[2 * 65], s[3 * 65]); o.z = cvt_pk_bf16(s[4 * 65], s[5 * 65]); o.w = cvt_pk_bf16(s[6 * 65], s[7 * 65]);
    *(u32x4*)(dst + (size_t)(nd0 + n) * K + k0 + kc) = o;
    __syncthreads();
}
__device__ __forceinline__ void prep_phase(const Params& p, LAS unsigned char* lds) {
    LAS float* scr = (LAS float*)lds;
    unsigned char* ws = p.ws;
    const int G = gridDim.x, bx = blockIdx.x, tid = threadIdx.x, lane = tid & 63, wv = tid >> 6;
    constexpr int NW = 15;
    const float* srcs[NW] = {p.in[2], p.in[4], p.in[17], p.in[17] + (size_t)1024 * 5632, p.in[18], p.in[18] + (size_t)FF * 1024, p.in[6], p.in[14], p.in[8], p.in[11], p.in[15], p.in[9], p.in[12],
                             p.in[8] + (size_t)1024 * 256, p.in[11] + (size_t)1024 * 256};
    const int Ks[NW] = {1024, 1024, 1024, 1024, FF, FF, 1024, 1024, 1024, 1024, 1024, 256, 256, 1024, 1024};
    const int Nsrcs[NW] = {3072, 1024, 5632, 5632, 1024, 1024, 1536, 1072, 256, 256, 1024, 64, 64, 256, 256};
    const int Ndsts[NW] = {3072, 1024, 5632, 5632, 1024, 1024, 1536, 1280, 256, 256, 1024, 64, 64, 256, 256};
    const size_t dsts[NW] = {WS_WIN, WS_WOUT, WS_WGU0, WS_WGU1, WS_WDN0, WS_WDN1, WS_WKVQG, WS_WKVQG + (size_t)1536 * 1024 * 2, WS_WC1, WS_WC1 + (size_t)2 * 256 * 1024 * 2, WS_WO, WS_WC2, WS_WC2 + 64 * 256 * 2,
                             WS_WC1 + (size_t)1 * 256 * 1024 * 2, WS_WC1 + (size_t)3 * 256 * 1024 * 2};
    const int kinds[NW] = {1, 0, 2, 2, 0, 0, 0, 0, 0, 0, 0, 0, 0, 0, 0};
    const float* gains[NW] = {p.in[1], nullptr, p.in[16], p.in[16] + 1024, nullptr, nullptr, p.in[5], p.in[13], nullptr, nullptr, nullptr, nullptr, nullptr, nullptr, nullptr};
    int base = 0;
#pragma unroll
    for (int wi = 0; wi < NW; ++wi) {
        const int nN64 = Ndsts[wi] / 64, nitems = (Ks[wi] / 64) * nN64;
        int first = (bx - base % G + G) % G;
        for (int it = first; it < nitems; it += G) transpose_item(srcs[wi], Ks[wi], Nsrcs[wi], (bf16_t*)(ws + dsts[wi]), kinds[wi], gains[wi], it, scr, nN64);
        base += nitems;
    }
    {
        const float* x = p.in[0]; bf16_t* hb = (bf16_t*)(ws + WS_HB); float* part = (float*)(ws + WS_PART);
        for (int r = bx * 8 + wv; r < T; r += G * 8) {
            const f32x4* xr = (const f32x4*)(x + (size_t)r * 1024);
            float ss = 0.f;
#pragma unroll
            for (int j = 0; j < 2; ++j) {
                const f32x4 a = __builtin_nontemporal_load(xr + j * 128 + lane * 2), b = __builtin_nontemporal_load(xr + j * 128 + lane * 2 + 1);
                ss += (a[0] * a[0] + a[1] * a[1]) + (a[2] * a[2] + a[3] * a[3]) + (b[0] * b[0] + b[1] * b[1]) + (b[2] * b[2] + b[3] * b[3]);
                *(u32x4*)(hb + (size_t)r * 1024 + j * 512 + lane * 8) = pack8(a, b);
            }
#pragma unroll
            for (int o = 1; o < 64; o <<= 1) ss += __shfl_xor(ss, o);
            if (lane < 16) part[(size_t)r * 16 + lane] = (lane == 0) ? ss : 0.f;
        }
    }
    if (bx == 0) { unsigned* bw = (unsigned*)(ws + WS_BAR); for (int i = tid; i < 3456; i += 512) __hip_atomic_store(bw + i, 0u, __ATOMIC_RELAXED, __HIP_MEMORY_SCOPE_AGENT); }
    if (bx == 1 && tid < 17) __hip_atomic_store((unsigned*)(ws + WS_KMAX) + tid, 0u, __ATOMIC_RELAXED, __HIP_MEMORY_SCOPE_AGENT);
    if (bx < 2 && tid < 256) {
        const float* pe = p.in[bx == 0 ? 7 : 10]; const float* w1 = p.in[bx == 0 ? 8 : 11];
        float a = 0.f;
        for (int i = 0; i < 2048; ++i) a += pe[i] * w1[(size_t)i * 256 + tid];
        ((float*)(ws + WS_CBIAS))[bx * 256 + tid] = a;
    }
}

__device__ __forceinline__ void conv_phase(const Params& p) {
    unsigned char* ws = p.ws;
    const bf16_t* cv = (const bf16_t*)(ws + WS_CV); const bf16_t* bg = (const bf16_t*)(ws + WS_BG); bf16_t* uo = (bf16_t*)(ws + WS_U);
    const float* cw = p.in[3];
    const size_t total = (size_t)T * 128, stride = (size_t)gridDim.x * 512;
    for (size_t idx = (size_t)blockIdx.x * 512 + threadIdx.x; idx < total; idx += stride) {
        const int t = (int)(idx >> 7), c8 = (int)(idx & 127) * 8, s = t & 8191;
        const u32x4 z = (u32x4){0u, 0u, 0u, 0u};
        const u32x4 x2 = *(const u32x4*)(cv + (size_t)t * 1024 + c8);
        const u32x4 x1 = s >= 1 ? *(const u32x4*)(cv + (size_t)(t - 1) * 1024 + c8) : z;
        const u32x4 x0 = s >= 2 ? *(const u32x4*)(cv + (size_t)(t - 2) * 1024 + c8) : z;
        const u32x4 bb = *(const u32x4*)(bg + (size_t)t * 1024 + c8);
        const f32x4 w0a = *(const f32x4*)(cw + c8), w0b = *(const f32x4*)(cw + c8 + 4);
        const f32x4 w1a = *(const f32x4*)(cw + 1024 + c8), w1b = *(const f32x4*)(cw + 1024 + c8 + 4);
        const f32x4 w2a = *(const f32x4*)(cw + 2048 + c8), w2b = *(const f32x4*)(cw + 2048 + c8 + 4);
        f32x4 oa, ob;
#pragma unroll
        for (int j = 0; j < 2; ++j) {
            oa[2 * j] = bf_lo(bb[j]) * (w0a[2 * j] * bf_lo(x0[j]) + w1a[2 * j] * bf_lo(x1[j]) + w2a[2 * j] * bf_lo(x2[j]));
            oa[2 * j + 1] = bf_hi(bb[j]) * (w0a[2 * j + 1] * bf_hi(x0[j]) + w1a[2 * j + 1] * bf_hi(x1[j]) + w2a[2 * j + 1] * bf_hi(x2[j]));
            ob[2 * j] = bf_lo(bb[2 + j]) * (w0b[2 * j] * bf_lo(x0[2 + j]) + w1b[2 * j] * bf_lo(x1[2 + j]) + w2b[2 * j] * bf_lo(x2[2 + j]));
            ob[2 * j + 1] = bf_hi(bb[2 + j]) * (w0b[2 * j + 1] * bf_hi(x0[2 + j]) + w1b[2 * j + 1] * bf_hi(x1[2 + j]) + w2b[2 * j + 1] * bf_hi(x2[2 + j]));
        }
        *(u32x4*)(uo + (size_t)t * 1024 + c8) = pack8(oa, ob);
    }
}

__device__ __forceinline__ void cmp2_phase(const Params& p) {
    unsigned char* ws = p.ws;
    const bf16_t* pb0 = (const bf16_t*)(ws + WS_O); const bf16_t* pb1 = pb0 + (size_t)16384 * 256; const float* cbias = (const float*)(ws + WS_CBIAS);
    const bf16_t* w2t = (const bf16_t*)(ws + WS_WC2);
    bf16_t* kcmp = (bf16_t*)(ws + WS_KCMP); bf16_t* vcmp = (bf16_t*)(ws + WS_VCMP);
    const int tid = threadIdx.x, lane = tid & 63, wv = tid >> 6, i16 = lane & 15, slab = lane >> 4;
    for (int un = blockIdx.x; un < 256; un += gridDim.x) {
        const int R0 = un * 64, set = R0 >> 13;
        const int rt = wv >> 1;
        const size_t aoff = (size_t)(R0 + 16 * rt + i16) * 256 + 8 * slab;
        u32x4 pw0[8], pw1[8]; f32x4 pba[8], pbb[8];
#pragma unroll
        for (int ks = 0; ks < 8; ++ks) { pw0[ks] = *(const u32x4*)(pb0 + aoff + 32 * ks); pw1[ks] = *(const u32x4*)(pb1 + aoff + 32 * ks);
            pba[ks] = *(const f32x4*)(cbias + set * 256 + 32 * ks + 8 * slab); pbb[ks] = *(const f32x4*)(cbias + set * 256 + 32 * ks + 8 * slab + 4); }
        f32x4 c[2] = {(f32x4){0.f, 0.f, 0.f, 0.f}, (f32x4){0.f, 0.f, 0.f, 0.f}};
        float amax = 0.f;
#pragma unroll
        for (int ks = 0; ks < 8; ++ks) {
            const u32x4 w0 = pw0[ks], w1 = pw1[ks]; const f32x4 ba = pba[ks], bb = pbb[ks];
            f32x4 h0, h1;
            h0[0] = silu_f(bf_lo(w0.x) + bf_lo(w1.x) + ba[0]); h0[1] = silu_f(bf_hi(w0.x) + bf_hi(w1.x) + ba[1]);
            h0[2] = silu_f(bf_lo(w0.y) + bf_lo(w1.y) + ba[2]); h0[3] = silu_f(bf_hi(w0.y) + bf_hi(w1.y) + ba[3]);
            h1[0] = silu_f(bf_lo(w0.z) + bf_lo(w1.z) + bb[0]); h1[1] = silu_f(bf_hi(w0.z) + bf_hi(w1.z) + bb[1]);
            h1[2] = silu_f(bf_lo(w0.w) + bf_lo(w1.w) + bb[2]); h1[3] = silu_f(bf_hi(w0.w) + bf_hi(w1.w) + bb[3]);
            const u32x4 aw = pack8(h0, h1);
            const bf16x8 a = *(const bf16x8*)&aw;
#pragma unroll
            for (int cc = 0; cc < 2; ++cc) {
                const int ct = (wv & 1) * 2 + cc;
                const bf16x8 b = *(const bf16x8*)(w2t + (size_t)set * 64 * 256 + (size_t)(16 * ct + i16) * 256 + 32 * ks + 8 * slab);
                c[cc] = __builtin_amdgcn_mfma_f32_16x16x32_bf16(a, b, c[cc], 0, 0, 0);
            }
        }
#pragma unroll
        for (int cc = 0; cc < 2; ++cc) {
            const int n = 16 * ((wv & 1) * 2 + cc) + i16;
#pragma unroll
            for (int r = 0; r < 4; ++r) {
                const int R = R0 + 16 * rt + 4 * slab + r, rr = R & 8191, bgi = rr >> 9, nn = rr & 511;
                const float v = (nn == 511) ? 0.f : c[cc][r];
                const bf16_t hv = f2bf_sw(v);
                if (set == 0) kcmp[((size_t)bgi * 512 + nn) * 64 + n] = hv;
                else vcmp[(((size_t)bgi * 8 + (nn >> 6)) * 64 + n) * 64 + (nn & 63)] = hv;
                amax = fmaxf(amax, fabsf(v));
            }
        }
        if (set == 0) {
#pragma unroll
            for (int o = 1; o < 64; o <<= 1) amax = fmaxf(amax, __shfl_xor(amax, o));
            if (lane == 0) __hip_atomic_fetch_max((unsigned*)(ws + WS_KMAX) + ((R0 & 8191) >> 9), __float_as_uint(amax), __ATOMIC_RELAXED, __HIP_MEMORY_SCOPE_AGENT);
        }
    }
}

constexpr int KP = 72;
constexpr int IMP_P = 132;
constexpr int A_K = 0, A_V = 24576, A_IMP = 49152, A_WUN = A_IMP + 64 * IMP_P * 4, A_TL = A_WUN + 128, A_SEL = A_TL + 512, A_OFIN = 86016;

template <bool MASK, int KIND>
__device__ __forceinline__ void attn_tile(const LAS bf16_t* Kb, const LAS bf16_t* Vb, const bf16x8 (&qf)[2][2], f32x4 (&O)[2][4], float (&m)[2], float (&l)[2],
                                          const float (&lb)[2], const float (&slope2)[2], const float skmul, int lo, int hi, int col, int slab, LAS float* imp_row, int jbase) {
    const int sw = (col >> 1) & 7;
    constexpr float LAZY_THR = 12.0f;
    f32x4 sc[2][4];
    float mref[2];
#pragma unroll
    for (int ct = 0; ct < 2; ++ct) {
        const float skv = slope2[ct] * skmul;
        mref[ct] = (m[ct] < -1e19f) ? 0.f : m[ct];
        const float lbr = lb[ct] - mref[ct];
#pragma unroll
        for (int st = 0; st < 4; ++st) { const float c0 = fmaf(skv, (float)(16 * st), lbr); sc[ct][st] = (f32x4){c0, c0 + skv, fmaf(skv, 2.f, c0), fmaf(skv, 3.f, c0)}; }
    }
#pragma unroll
    for (int st = 0; st < 4; ++st) {
#pragma unroll
        for (int ks = 0; ks < 2; ++ks) {
            const bf16x8 kf = *(const LAS bf16x8*)(Kb + (16 * st + col) * 64 + (((4 * ks + slab) ^ sw) << 3));
#pragma unroll
            for (int ct = 0; ct < 2; ++ct) sc[ct][st] = __builtin_amdgcn_mfma_f32_16x16x32_bf16(kf, qf[ct][ks], sc[ct][st], 0, 0, 0);
        }
        asm volatile("" ::: "memory");
    }
    if (MASK) {
        const int lo2 = lo - 4 * slab, hi2 = hi - 4 * slab;
#pragma unroll
        for (int ct = 0; ct < 2; ++ct)
#pragma unroll
            for (int st = 0; st < 4; ++st)
#pragma unroll
                for (int r = 0; r < 4; ++r) { const int kk = 16 * st + r; sc[ct][st][r] = (kk >= lo2 && kk <= hi2) ? sc[ct][st][r] : -1e30f; }
    }
    if (KIND != 2) {
        float mxl[2];
#pragma unroll
        for (int ct = 0; ct < 2; ++ct) {
            float mx = -1e30f;
#pragma unroll
            for (int st = 0; st < 4; ++st) mx = fmaxf(fmaxf(mx, fmaxf(sc[ct][st][0], sc[ct][st][1])), fmaxf(sc[ct][st][2], sc[ct][st][3]));
            mxl[ct] = mx;
        }
        const bool slow = __any((mxl[0] > LAZY_THR) || (mxl[1] > LAZY_THR) || (m[0] < -1e19f) || (m[1] < -1e19f));
        if (slow) {
#pragma unroll
            for (int ct = 0; ct < 2; ++ct) {
                const float mx = xmax_16_32(mxl[ct]);
                const float mrel = m[ct] - mref[ct];
                const float mn = fmaxf(mrel, mx);
                const float alpha = __builtin_amdgcn_exp2f(mrel - mn);
                m[ct] = mref[ct] + mn; l[ct] *= alpha;
#pragma unroll
                for (int st = 0; st < 4; ++st) sc[ct][st] = sc[ct][st] - mn;
                if (KIND == 0) {
#pragma unroll
                    for (int dt = 0; dt < 4; ++dt) O[ct][dt] = O[ct][dt] * alpha;
                }
            }
        }
    }
#pragma unroll
    for (int ct = 0; ct < 2; ++ct) {
        f32x4 sum4 = (f32x4){0.f, 0.f, 0.f, 0.f};
#pragma unroll
        for (int st = 0; st < 4; ++st) {
            f32x4 e;
#pragma unroll
            for (int r = 0; r < 4; ++r) e[r] = __builtin_amdgcn_exp2f(sc[ct][st][r]);
            if (KIND == 2) e = e * l[ct];
            sc[ct][st] = e; sum4 += e;
        }
        if (KIND != 2) l[ct] += (sum4[0] + sum4[1]) + (sum4[2] + sum4[3]);
    }
    if (KIND == 1) return;
    if (KIND == 2) {
#pragma unroll
        for (int st = 0; st < 4; ++st) {
            float g4 = (sc[0][st][0] + sc[0][st][1]) + (sc[0][st][2] + sc[0][st][3]) + (sc[1][st][0] + sc[1][st][1]) + (sc[1][st][2] + sc[1][st][3]);
            g4 += __shfl_xor(g4, 8);
            if ((col & 8) == 0) imp_row[jbase + 4 * st + slab] += g4;
        }
        asm volatile("s_waitcnt lgkmcnt(0)" ::: "memory");
#pragma unroll
        for (int st = 0; st < 4; ++st) {
            float la = sc[0][st][3] + sc[1][st][3];
            la += __shfl_xor(la, 8);
            if ((col & 8) == 0) imp_row[jbase + 4 * st + slab + 1] += la;
        }
    }
#pragma unroll
    for (int ks2 = 0; ks2 < 2; ++ks2) {
        bf16x8 pf[2];
#pragma unroll
        for (int ct = 0; ct < 2; ++ct) { const u32x4 w = pack8(sc[ct][2 * ks2], sc[ct][2 * ks2 + 1]); pf[ct] = *(const bf16x8*)&w; }
#pragma unroll
        for (int dt = 0; dt < 4; ++dt) {
            const LAS bf16_t* vrow = Vb + (16 * dt + col) * 64 + 4 * (slab & 1);
            const int vc = (4 * ks2 + (slab >> 1)) ^ sw;
            const u32x2 a0 = *(const LAS u32x2*)(vrow + (vc << 3)), a1 = *(const LAS u32x2*)(vrow + ((vc ^ 2) << 3));
            const u32x4 aw = (u32x4){a0.x, a0.y, a1.x, a1.y};
            const bf16x8 vf = *(const bf16x8*)&aw;
#pragma unroll
            for (int ct = 0; ct < 2; ++ct) O[ct][dt] = __builtin_amdgcn_mfma_f32_16x16x32_bf16(vf, pf[ct], O[ct][dt], 0, 0, 0);
            asm volatile("" ::: "memory");
        }
    }
}

__device__ __forceinline__ int sum_jg(int x) {
    x += __builtin_amdgcn_update_dpp(0, x, 0x128, 0xf, 0xf, false);
    auto a = __builtin_amdgcn_permlane16_swap((unsigned)x, (unsigned)x, false, false);
    x = (int)(a[0] + a[1]);
    auto b = __builtin_amdgcn_permlane32_swap((unsigned)x, (unsigned)x, false, false);
    return (int)(b[0] + b[1]);
}
__device__ __forceinline__ unsigned pick4(const unsigned (&a)[4], int i) { return i == 0 ? a[0] : (i == 1 ? a[1] : (i == 2 ? a[2] : a[3])); }
__device__ __forceinline__ void attn_phase(const Params& p, LAS unsigned char* lds) {
    unsigned char* ws = p.ws;
    const bf16_t* qbuf = (const bf16_t*)(ws + WS_Q); const float* gates = (const float*)(ws + WS_GATES);
    const bf16_t* kcmp = (const bf16_t*)(ws + WS_KCMP); const bf16_t* vcmp = (const bf16_t*)(ws + WS_VCMP);
    const bf16_t* kslc = (const bf16_t*)(ws + WS_KSLC); const bf16_t* vslc = (const bf16_t*)(ws + WS_VSLC);
    const bf16_t* kwin = (const bf16_t*)(ws + WS_KWIN); const bf16_t* vwin = (const bf16_t*)(ws + WS_VWIN);
    bf16_t* obuf = (bf16_t*)(ws + WS_O);
    const int tid = threadIdx.x, lane = tid & 63, w = __builtin_amdgcn_readfirstlane(tid >> 6), col = lane & 15, slab = lane >> 4, qi = lane & 7;
    LAS bf16_t* Ksm = (LAS bf16_t*)(lds + A_K); LAS bf16_t* Vsm = (LAS bf16_t*)(lds + A_V);
    LAS float* imp = (LAS float*)(lds + A_IMP); LAS unsigned* wun = (LAS unsigned*)(lds + A_WUN); LAS unsigned short* tl = (LAS unsigned short*)(lds + A_TL);
    LAS float* imp_row = imp + (8 * w + qi) * IMP_P;
    LAS unsigned* selw = (LAS unsigned*)(lds + A_SEL) + (8 * w + qi) * 4;
    const int dsrc = (tid >> 3) * 64 + ((((tid & 7) ^ ((tid >> 4) & 7))) << 3);
#define ATT_DMA(kptr, vptr, buf) do { \
        __builtin_amdgcn_global_load_lds((const unsigned*)((kptr) + dsrc), (LAS unsigned*)(lds + A_K + (buf) * 8192 + w * 1024), 16, 0, 0); \
        __builtin_amdgcn_global_load_lds((const unsigned*)((vptr) + dsrc), (LAS unsigned*)(lds + A_V + (buf) * 8192 + w * 1024), 16, 0, 0); } while (0)
#define ATT_WAIT(more) do { if (more) asm volatile("s_waitcnt vmcnt(2)" ::: "memory"); else asm volatile("s_waitcnt vmcnt(0)" ::: "memory"); \
        __builtin_amdgcn_s_barrier(); asm volatile("" ::: "memory"); } while (0)

    unsigned* qctr = (unsigned*)(ws + WS_KMAX) + 16;
    LAS int* qslot = (LAS int*)(lds + A_TL + 448);
    if (tid == 0) qslot[0] = (int)__hip_atomic_fetch_add(qctr, 1u, __ATOMIC_RELAXED, __HIP_MEMORY_SCOPE_AGENT);
    __syncthreads();
    int ui = __builtin_amdgcn_readfirstlane(qslot[0]);
    while (ui < 2048) {
        int nxt_ui = 0;
        const int qb = 127 - (ui >> 4), bgi = ui & 15, b = bgi >> 2, g = bgi & 3;
        const int ql = 8 * w + qi, t = qb * 64 + ql;
        const int tok = b * SEQ + t;
        bf16x8 qf[2][2]; float slope2[2]; int hh[2];
#pragma unroll
        for (int ct = 0; ct < 2; ++ct) {
            hh[ct] = 4 * g + 2 * ct + (col >> 3);
            slope2[ct] = exp2f(-0.5f * (float)(hh[ct] + 1)) * LOG2E;
#pragma unroll
            for (int ks = 0; ks < 2; ++ks) qf[ct][ks] = *(const bf16x8*)(qbuf + (size_t)tok * 1024 + hh[ct] * 64 + 32 * ks + 8 * slab);
        }
        for (int i = lane; i < 8 * IMP_P; i += 64) imp[8 * w * IMP_P + i] = 0.f;
        f32x4 O[2][4]; float m[2], l[2];
        LAS f32x4* ofin = (LAS f32x4*)(lds + A_OFIN) + tid;
#pragma unroll
        for (int ct = 0; ct < 2; ++ct) { m[ct] = -1e20f; l[ct] = 0.f;
#pragma unroll
            for (int dt = 0; dt < 4; ++dt) O[ct][dt] = (f32x4){0.f, 0.f, 0.f, 0.f}; }
        float lb[2]; float skmul;
        const int nkt = (4 * qb + 3 + 63) >> 6;
        const int nmax = (t - 31) >> 4;
        int nproc;
        {
            const float kinf = __uint_as_float(((const unsigned*)(ws + WS_KMAX))[bgi]) * 1.01f;
            int kneed = nkt - 1;
#pragma unroll
            for (int ct = 0; ct < 2; ++ct) {
                float qn = 0.f;
#pragma unroll
                for (int ks = 0; ks < 2; ++ks)
#pragma unroll
                    for (int e = 0; e < 8; ++e) qn += __uint_as_float(((unsigned)(unsigned short)qf[ct][ks][e] & 0x7fffu) << 16);
                qn = xsum_16_32(qn) * 1.001f;
                const float X = ((float)t - 1055.f - (170.f + 2.f * qn * kinf) / slope2[ct]) * (1.0f / 1024.0f);
                const int kn = X > 0.f ? (int)ceilf(X) : 0;
                kneed = kn < kneed ? kn : kneed;
            }
#pragma unroll
            for (int o = 1; o < 16; o <<= 1) { const int other = __shfl_xor(kneed, o); kneed = other < kneed ? other : kneed; }
            LAS int* knw = (LAS int*)(lds + A_TL + 384);
            if (lane == 0) knw[w] = kneed;
            __syncthreads();
            int ktmin = knw[0];
#pragma unroll
            for (int w2 = 1; w2 < 8; ++w2) { const int v = knw[w2]; ktmin = v < ktmin ? v : ktmin; }
            nproc = nkt - __builtin_amdgcn_readfirstlane(ktmin);
        }
        const int n1 = 2 * nproc;
        const bf16_t* kc0 = kcmp + (size_t)bgi * 512 * 64; const bf16_t* vc0 = vcmp + (size_t)bgi * 8 * 4096;
#define KT1(i) (nkt - 1 - (((i) < nproc) ? (i) : (i) - nproc))
        asm volatile("" :: "v"(qf[0][0]), "v"(qf[0][1]), "v"(qf[1][0]), "v"(qf[1][1]));
        if (tid == 0) nxt_ui = (int)__hip_atomic_fetch_add(qctr, 1u, __ATOMIC_RELAXED, __HIP_MEMORY_SCOPE_AGENT);
        ATT_DMA(kc0 + KT1(0) * 4096, vc0 + KT1(0) * 4096, 0);
        ATT_DMA(kc0 + KT1(1) * 4096, vc0 + KT1(1) * 4096, 1);
        skmul = 16.f;
        const int nmax_min = (qb * 64 + 8 * w - 31) >> 4;
        int cb = 0;
        for (int i = 0; i < n1; ++i) {
            ATT_WAIT(i + 1 < n1);
            if (i + 2 < n1) { const int nb = cb == 0 ? 2 : cb - 1; ATT_DMA(kc0 + KT1(i + 2) * 4096, vc0 + KT1(i + 2) * 4096, nb); }
            const LAS bf16_t* Kb = Ksm + cb * 4096; const LAS bf16_t* Vb = Vsm + cb * 4096;
            cb = cb == 2 ? 0 : cb + 1;
            const int kt = KT1(i);
#pragma unroll
            for (int ct = 0; ct < 2; ++ct) lb[ct] = slope2[ct] * (16.f * (float)(64 * kt + 4 * slab) + 15.5f - (float)t);
            const int hi = nmax - 64 * kt;
            const bool cmask = (64 * kt + 63 > nmax_min);
            if (i < nproc) { if (cmask) attn_tile<true, 1>(Kb, Vb, qf, O, m, l, lb, slope2, skmul, 0, hi, col, slab, imp_row, 0);
                           else attn_tile<false, 1>(Kb, Vb, qf, O, m, l, lb, slope2, skmul, 0, 63, col, slab, imp_row, 0); }
            else {
                if (i == nproc) {
#pragma unroll
                    for (int ct = 0; ct < 2; ++ct) { float lt = xsum_16_32(l[ct]); l[ct] = lt > 0.f ? fast_rcp(lt) : 0.f; }
                }
                if (cmask) attn_tile<true, 2>(Kb, Vb, qf, O, m, l, lb, slope2, skmul, 0, hi, col, slab, imp_row, 16 * kt);
                else attn_tile<false, 2>(Kb, Vb, qf, O, m, l, lb, slope2, skmul, 0, 63, col, slab, imp_row, 16 * kt);
            }
        }
        {
#pragma unroll
            for (int ct = 0; ct < 2; ++ct) { const float g0 = gates[(size_t)tok * 48 + hh[ct] * 3 + 0];
#pragma unroll
                for (int dt = 0; dt < 4; ++dt) { ofin[(ct * 4 + dt) * 512] = O[ct][dt] * g0; O[ct][dt] = (f32x4){0.f, 0.f, 0.f, 0.f}; }
                m[ct] = -1e20f; l[ct] = 0.f; }
        }
        unsigned sel[4];
        {
            const int jg = lane >> 3;
            unsigned m16 = 0;
            if (qb - 2 <= 13) {
#pragma unroll
                for (int e = 0; e < 16; ++e) if (16 * jg + e <= qb) m16 |= 1u << e;
            } else {
                unsigned key[16];
#pragma unroll
                for (int e = 0; e < 16; ++e) { const int j = 16 * jg + e; const float v = imp_row[j]; key[e] = (j >= 1 && j <= qb - 2) ? (__float_as_uint(v) + 1u) : 0u; }
                unsigned Tt = 0;
                for (int bit = 30; bit >= 0; --bit) {
                    const unsigned cand = Tt | (1u << bit); int cnt = 0;
#pragma unroll
                    for (int e = 0; e < 16; ++e) cnt += (key[e] >= cand) ? 1 : 0;
                    cnt = sum_jg(cnt);
                    if (cnt >= 13) Tt = cand;
                }
                int cgt = 0, ceq = 0;
#pragma unroll
                for (int e = 0; e < 16; ++e) { cgt += (key[e] > Tt) ? 1 : 0; ceq += (key[e] == Tt) ? 1 : 0; }
                cgt = sum_jg(cgt);
                const int need = 13 - cgt;
                int run = 0;
#pragma unroll
                for (int j2 = 0; j2 < 8; ++j2) { const int c = __shfl(ceq, qi + 8 * j2); if (j2 < jg) run += c; }
#pragma unroll
                for (int e = 0; e < 16; ++e) {
                    if (key[e] > Tt) m16 |= 1u << e;
                    else if (key[e] == Tt) { if (run < need) m16 |= 1u << e; ++run; }
                }
#pragma unroll
                for (int e = 0; e < 16; ++e) { const int j = 16 * jg + e; if (j == 0 || j == qb || j == qb - 1) m16 |= 1u << e; }
            }
            sel[0] = sel[1] = sel[2] = sel[3] = 0u;
#pragma unroll
            for (int j2 = 0; j2 < 8; ++j2) { const unsigned v = (unsigned)__shfl((int)m16, qi + 8 * j2); sel[j2 >> 1] |= v << (16 * (j2 & 1)); }
        }
        if (lane < 8) {
#pragma unroll
            for (int k4 = 0; k4 < 4; ++k4) selw[k4] = sel[k4];
        }
        unsigned wu[4];
#pragma unroll
        for (int k4 = 0; k4 < 4; ++k4) { unsigned x = sel[k4]; x |= (unsigned)__shfl_xor((int)x, 1); x |= (unsigned)__shfl_xor((int)x, 2); x |= (unsigned)__shfl_xor((int)x, 4); wu[k4] = (unsigned)__builtin_amdgcn_readfirstlane((int)x); if (lane == 0) wun[w * 4 + k4] = x; }
        __syncthreads();
        unsigned un[4] = {0u, 0u, 0u, 0u};
#pragma unroll
        for (int w2 = 0; w2 < 8; ++w2)
#pragma unroll
            for (int k4 = 0; k4 < 4; ++k4) un[k4] |= wun[w2 * 4 + k4];
#pragma unroll
        for (int k4 = 0; k4 < 4; ++k4) un[k4] = (unsigned)__builtin_amdgcn_readfirstlane((int)un[k4]);
        const int nslc = __popc(un[0]) + __popc(un[1]) + __popc(un[2]) + __popc(un[3]);
        const int jw0 = qb >= 8 ? qb - 8 : 0, nwin = qb - jw0 + 1, n2 = nslc + nwin;
        int tidl = tid; asm volatile("" : "+v"(tidl));
        if (tidl < 128) {
            const int j = tidl, wd = j >> 5, bi = j & 31;
            const unsigned uw = pick4(un, wd);
            if ((uw >> bi) & 1u) {
                int pos = __popc(uw & ((1u << bi) - 1u));
#pragma unroll
                for (int k4 = 0; k4 < 4; ++k4) if (k4 < wd) pos += __popc(un[k4]);
                tl[nslc - 1 - pos] = (unsigned short)j;
            }
        } else if (tidl < 128 + nwin) tl[nslc + (tidl - 128)] = (unsigned short)(0x100 | (qb - (tidl - 128)));
        __syncthreads();
        {
            skmul = 1.f;
#define ATT_DMA2(idx, buf) do { const int _e = tl[idx]; const int _j = _e & 0xff; const bool _w = _e >> 8; \
                ATT_DMA((_w ? kwin : kslc) + ((size_t)bgi * SEQ + 64 * _j) * 64, (_w ? vwin : vslc) + ((size_t)bgi * 128 + _j) * 4096, buf); } while (0)
            ATT_DMA2(0, 0);
            ATT_DMA2(1, 1);
            int cb = 0;
            for (int i = 0; i < n2; ++i) {
                ATT_WAIT(i + 1 < n2);
                if (i + 2 < n2) { const int nb = cb == 0 ? 2 : cb - 1; ATT_DMA2(i + 2, nb); }
                const int buf3 = cb; cb = cb == 2 ? 0 : cb + 1;
                const int e = tl[i];
                const int j = e & 0xff; const bool isw = e >> 8;
#pragma unroll
                for (int ct = 0; ct < 2; ++ct) lb[ct] = slope2[ct] * ((float)(64 * j + 4 * slab) - (float)t);
                const LAS bf16_t* Kb = Ksm + buf3 * 4096; const LAS bf16_t* Vb = Vsm + buf3 * 4096;
                if (isw && i == nslc) {
#pragma unroll
                    for (int ct = 0; ct < 2; ++ct) { float lt = xsum_16_32(l[ct]);
                        const float sc1 = (lt > 0.f ? fast_rcp(lt) : 0.f) * gates[(size_t)tok * 48 + hh[ct] * 3 + 1];
#pragma unroll
                        for (int dt = 0; dt < 4; ++dt) { ofin[(ct * 4 + dt) * 512] += O[ct][dt] * sc1; O[ct][dt] = (f32x4){0.f, 0.f, 0.f, 0.f}; }
                        m[ct] = -1e20f; l[ct] = 0.f; }
                }
                int tlo = 0, thi = 63; bool active = true, domask = false;
                if (!isw) {
                    active = (pick4(wu, j >> 5) >> (j & 31)) & 1u;
                    const bool cval = (selw[j >> 5] >> (j & 31)) & 1u;
                    thi = cval ? (j == qb ? ql : 63) : -1;
                    domask = (j == qb) || !__all(cval);
                } else {
                    if (j == qb) { thi = ql; domask = true; }
                    else if (j == qb - 8) { tlo = ql + 1; domask = true; }
                }
                if (active) {
                    if (domask) attn_tile<true, 0>(Kb, Vb, qf, O, m, l, lb, slope2, skmul, tlo, thi, col, slab, imp_row, 0);
                    else attn_tile<false, 0>(Kb, Vb, qf, O, m, l, lb, slope2, skmul, 0, 63, col, slab, imp_row, 0);
                }
            }
        }
#pragma unroll
        for (int ct = 0; ct < 2; ++ct) { float lt = xsum_16_32(l[ct]);
            const float sc2 = (lt > 0.f ? fast_rcp(lt) : 0.f) * gates[(size_t)tok * 48 + hh[ct] * 3 + 2];
#pragma unroll
            for (int dt = 0; dt < 4; ++dt) {
                const f32x4 o = ofin[(ct * 4 + dt) * 512] + O[ct][dt] * sc2;
                u32x2 wv2; wv2.x = cvt_pk_bf16(o[0], o[1]); wv2.y = cvt_pk_bf16(o[2], o[3]);
                *(u32x2*)(obuf + (size_t)tok * 1024 + hh[ct] * 64 + 16 * dt + 4 * slab) = wv2;
            } }
        if (tid == 0) qslot[0] = nxt_ui;
        __syncthreads();
        ui = __builtin_amdgcn_readfirstlane(qslot[0]);
    }
}

__device__ __forceinline__ void final_phase(const Params& p) {
    float* out = p.out; const bf16_t* hb = (const bf16_t*)(p.ws + WS_HB); const float* part = (const float*)(p.ws + WS_PART) + (size_t)4 * T * 16; const float* gn = p.in[19];
    const int lane = threadIdx.x & 63, wv = threadIdx.x >> 6;
    for (int r = blockIdx.x * 8 + wv; r < T; r += gridDim.x * 8) {
        const float rs = row_rstd(part, r);
#pragma unroll
        for (int j = 0; j < 2; ++j) {
            const u32x4 w = *(const u32x4*)(hb + (size_t)r * 1024 + j * 512 + lane * 8);
            const f32x4 g0 = *(const f32x4*)(gn + j * 512 + lane * 8), g1 = *(const f32x4*)(gn + j * 512 + lane * 8 + 4);
            f32x4* o = (f32x4*)(out + (size_t)r * 1024 + j * 512 + lane * 8);
            __builtin_nontemporal_store((f32x4){bf_lo(w.x), bf_hi(w.x), bf_lo(w.y), bf_hi(w.y)} * rs * g0, o);
            __builtin_nontemporal_store((f32x4){bf_lo(w.z), bf_hi(w.z), bf_lo(w.w), bf_hi(w.w)} * rs * g1, o + 1);
        }
    }
}

#define XB_TMO      128
#define XB_XCNT(j)  (256  + 64 * (j))
#define XB_XSUB(j)  (1280 + 64 * (j))
#define XB_XGEN(j)  (2304 + 64 * (j))
#define XB_TOP      3328
#define XB_TOPGEN   3392
#define XCD_BAR_WORDS 3456
#define XB_SPIN_CAP (1u << 18)
__device__ __forceinline__ unsigned xb_ld(unsigned* p)              { return __hip_atomic_load(p, __ATOMIC_RELAXED, __HIP_MEMORY_SCOPE_AGENT); }
__device__ __forceinline__ unsigned xb_add(unsigned* p, unsigned v) { return __hip_atomic_fetch_add(p, v, __ATOMIC_RELAXED, __HIP_MEMORY_SCOPE_AGENT); }
__device__ __forceinline__ unsigned xb_xcc_id() { return (unsigned)__builtin_amdgcn_s_getreg((3 << 11) | 20) & 0xFu; }
#define XB_SPIN(cond, bar) do { unsigned _sp = 0; while (cond) { __builtin_amdgcn_s_sleep(1); \
    if ((++_sp & 255u) == 0u) { if (xb_ld(&(bar)[XB_TMO])) break; if (_sp > XB_SPIN_CAP) { atomicAdd(&(bar)[XB_TMO], 1u); break; } } } } while (0)
struct XcdBarrier { unsigned* bar; unsigned x; volatile LAS unsigned* st; };
__device__ __forceinline__ XcdBarrier xcd_barrier_post(unsigned* bar, volatile LAS unsigned* st) {
    XcdBarrier b; b.bar = bar; b.x = xb_xcc_id(); b.st = st;
    if (threadIdx.x == 0) (void)xb_add(&bar[XB_XCNT(b.x)], 1u);
    return b;
}
__device__ __forceinline__ void xcd_barrier_complete(unsigned* bar, unsigned x, unsigned& nloc, unsigned& nx) {
    const unsigned G = gridDim.x * gridDim.y * gridDim.z;
    unsigned sum, cnt, mine, sp = 0u;
    for (;;) {
        sum = 0u; cnt = 0u; mine = 0u;
#pragma unroll
        for (unsigned j = 0; j < 16; ++j) { const unsigned c = xb_ld(&bar[XB_XCNT(j)]); sum += c; cnt += (c > 0u) ? 1u : 0u; mine = (j == x) ? c : mine; }
        if (sum == G) break;
        __builtin_amdgcn_s_sleep(1);
        if ((++sp & 255u) == 0u) { if (xb_ld(&bar[XB_TMO])) break; if (sp > XB_SPIN_CAP) { atomicAdd(&bar[XB_TMO], 1u); break; } }
    }
    nloc = mine > 0u ? mine : 1u; nx = cnt > 0u ? cnt : 1u;
}
__device__ __forceinline__ void xcd_barrier(const XcdBarrier& b) {
    asm volatile("s_waitcnt vmcnt(0)" ::: "memory");
    __syncthreads();
    if (threadIdx.x == 0) {
        unsigned* bar = b.bar;
        __builtin_amdgcn_s_waitcnt(0);
        unsigned nloc = b.st[0], nx = b.st[1];
        if (nloc == 0u) { xcd_barrier_complete(bar, b.x, nloc, nx); b.st[0] = nloc; b.st[1] = nx; }
        const unsigned old = xb_add(&bar[XB_XSUB(b.x)], 1u);
        const unsigned gen = old / nloc;
        if (old + 1u == (gen + 1u) * nloc) {
            __builtin_amdgcn_fence(__ATOMIC_RELEASE, "agent");
            asm volatile("s_waitcnt vmcnt(0)" ::: "memory");
            const unsigned og = xb_add(&bar[XB_TOP], 1u);
            const unsigned tg = og / nx;
            if (og + 1u == (tg + 1u) * nx) xb_add(&bar[XB_TOPGEN], 1u);
            else XB_SPIN(xb_ld(&bar[XB_TOPGEN]) == tg, bar);
            __builtin_amdgcn_fence(__ATOMIC_ACQUIRE, "agent");
            xb_add(&bar[XB_XGEN(b.x)], 1u);
            asm volatile("s_waitcnt vmcnt(0)" ::: "memory");
        } else {
            XB_SPIN(xb_ld(&bar[XB_XGEN(b.x)]) == gen, bar);
            __builtin_amdgcn_fence(__ATOMIC_ACQUIRE, "agent");
            asm volatile("s_waitcnt vmcnt(0)" ::: "memory");
        }
    }
    __syncthreads();
}

__global__ void __launch_bounds__(512, 2) fwd_megakernel(Params p) {
    extern __shared__ __attribute__((aligned(16))) unsigned char smem[];
    LAS unsigned char* lds = (LAS unsigned char*)smem;
    cg::grid_group grid = cg::this_grid();
    unsigned char* ws = p.ws;
    float* part = (float*)(ws + WS_PART);
    const int G = gridDim.x, bx = blockIdx.x;
    const int lo = p.ph_lo, hi = p.ph_hi;
#ifndef PH_MASK
#define PH_MASK 0xffff
#endif
#define IN(k) (((PH_MASK >> (k)) & 1) && lo <= (k) && (k) < hi)
    volatile LAS unsigned* xst = (volatile LAS unsigned*)(lds + LDS_BYTES - 16);
    if (threadIdx.x == 0) { xst[0] = 0u; xst[1] = 0u; }
    __syncthreads();
    XcdBarrier xbar; xbar.bar = (unsigned*)(ws + WS_BAR); xbar.x = 0u; xbar.st = xst;
#define SEAM(k) do { if (IN(k) && IN((k) + 1)) { if ((k) == 0) { grid.sync(); xbar = xcd_barrier_post((unsigned*)(ws + WS_BAR), xst); } else xcd_barrier(xbar); } } while (0)
    if (IN(0)) prep_phase(p, lds);
    SEAM(0);
    if (IN(1)) { pg8::Gemm g{(const bf16_t*)(ws + WS_HB), (const bf16_t*)(ws + WS_WIN), 1024, 1024}; pg8::StaticOrder S; S.init(T, 3072, G, bx);
        EpiWin E{part, (bf16_t*)(ws + WS_CV), (bf16_t*)(ws + WS_BG)}; pg8::gemm_phase(lds, g, S, E); }
    SEAM(1);
    if (IN(2)) conv_phase(p);
    SEAM(2);
    if (IN(3)) { pg8::Gemm g{(const bf16_t*)(ws + WS_U), (const bf16_t*)(ws + WS_WOUT), 1024, 1024}; pg8::StaticOrder S; S.init(T, 1024, G, bx);
        EpiResB E{(bf16_t*)(ws + WS_HB), part + (size_t)1 * T * 16}; pg8::gemm_phase(lds, g, S, E); }
    SEAM(3);
    if (IN(4)) { pg8::Gemm g{(const bf16_t*)(ws + WS_HB), (const bf16_t*)(ws + WS_WGU0), 1024, 1024}; pg8::StaticOrder S; S.init(T, 5632, G, bx);
        EpiGu E{part + (size_t)1 * T * 16, (bf16_t*)(ws + WS_HID)}; pg8::gemm_phase(lds, g, S, E); }
    SEAM(4);
    if (IN(5)) { pg8::Gemm g{(const bf16_t*)(ws + WS_HID), (const bf16_t*)(ws + WS_WDN0), FF, FF}; pg8::StaticOrder S; S.init(T, 1024, G, bx);
        EpiResB E{(bf16_t*)(ws + WS_HB), part + (size_t)2 * T * 16}; pg8::gemm_phase(lds, g, S, E); }
    SEAM(5);
    if (IN(6)) { pg8::Gemm g{(const bf16_t*)(ws + WS_HB), (const bf16_t*)(ws + WS_WKVQG), 1024, 1024}; pg8::StaticOrder S; S.init(T, 2560, G, bx);
        EpiKvqg E{part + (size_t)2 * T * 16, ws}; pg8::gemm_phase(lds, g, S, E); }
    SEAM(6);
    if (IN(7)) {
        const bool split = G >= 256;
        if (!split || bx < 128) { pg8::Gemm g{(const bf16_t*)(ws + WS_CMPRAW), (const bf16_t*)(ws + WS_WC1), 1024, 1024}; pg8::CmpOrder S{split ? 128 : G, bx};
            EpiCmp E{(bf16_t*)(ws + WS_O)}; pg8::gemm_phase(lds, g, S, E); }
        if (!split || bx >= 128) { pg8::Gemm g{(const bf16_t*)(ws + WS_HB), (const bf16_t*)(ws + WS_WKVQG), 1024, 1024}; pg8::GateOrder S{split ? G - 128 : G, split ? bx - 128 : bx};
            EpiKvqg E{part + (size_t)2 * T * 16, ws}; pg8::gemm_phase(lds, g, S, E); }
    }
    SEAM(7);
    if (IN(8)) cmp2_phase(p);
    SEAM(8);
    if (IN(9)) attn_phase(p, lds);
    SEAM(9);
    if (IN(10)) { pg8::Gemm g{(const bf16_t*)(ws + WS_O), (const bf16_t*)(ws + WS_WO), 1024, 1024}; pg8::StaticOrder S; S.init(T, 1024, G, bx);
        EpiResB E{(bf16_t*)(ws + WS_HB), part + (size_t)3 * T * 16}; pg8::gemm_phase(lds, g, S, E); }
    SEAM(10);
    if (IN(11)) { pg8::Gemm g{(const bf16_t*)(ws + WS_HB), (const bf16_t*)(ws + WS_WGU1), 1024, 1024}; pg8::StaticOrder S; S.init(T, 5632, G, bx);
        EpiGu E{part + (size_t)3 * T * 16, (bf16_t*)(ws + WS_HID)}; pg8::gemm_phase(lds, g, S, E); }
    SEAM(11);
    if (IN(12)) { pg8::Gemm g{(const bf16_t*)(ws + WS_HID), (const bf16_t*)(ws + WS_WDN1), FF, FF}; pg8::StaticOrder S; S.init(T, 1024, G, bx);
        EpiResB E{(bf16_t*)(ws + WS_HB), part + (size_t)4 * T * 16}; pg8::gemm_phase(lds, g, S, E); }
    SEAM(12);
    if (IN(13)) final_phase(p);
#ifdef DUMP_BASE
    SEAM(13);
    if (lo <= 14 && 14 < hi) {
        const unsigned short* src = (const unsigned short*)(ws + (size_t)(DUMP_BASE));
        const size_t n = (size_t)T * 1024;
        for (size_t i = (size_t)bx * 512 + threadIdx.x; i < n; i += (size_t)G * 512) p.out[i] = (float)src[i] + (float)src[i + n] + (float)src[i + 2 * n];
    }
#endif
}

#ifdef DUMP_BASE
constexpr int N_PHASES = 15;
#else
constexpr int N_PHASES = 14;
#endif
#ifndef N_LAUNCH_SPLIT
#define N_LAUNCH_SPLIT 0
#endif
extern "C" void kernel_launch(void* const* d_in, const int* in_sizes, int n_in, void* d_out, int out_size, void* d_ws, size_t ws_size, hipStream_t stream) {
    static int grid_blocks = 0;
    if (!grid_blocks) {
        int dev = 0, cus = 0, per_cu = 0;
        hipGetDevice(&dev);
        hipDeviceGetAttribute(&cus, hipDeviceAttributeMultiprocessorCount, dev);
        hipFuncSetAttribute((const void*)fwd_megakernel, hipFuncAttributeMaxDynamicSharedMemorySize, LDS_BYTES);
        hipOccupancyMaxActiveBlocksPerMultiprocessor(&per_cu, (const void*)fwd_megakernel, 512, LDS_BYTES);
        if (per_cu < 1) { fprintf(stderr, "occupancy query returned %d\n", per_cu); per_cu = 1; }
        grid_blocks = cus * 1;
    }
    Params p{};
    for (int i = 0; i < 20; ++i) p.in[i] = (const float*)d_in[i];
    p.out = (float*)d_out; p.ws = (unsigned char*)d_ws;
#if N_LAUNCH_SPLIT
    for (int ph = 0; ph < N_PHASES; ++ph) {
        p.ph_lo = ph; p.ph_hi = ph + 1;
        void* args[] = {&p};
        hipError_t e = hipLaunchCooperativeKernel((const void*)fwd_megakernel, dim3(grid_blocks), dim3(512), args, LDS_BYTES, stream);
        if (e != hipSuccess) fprintf(stderr, "cooperative launch failed: %s (grid %d)\n", hipGetErrorString(e), grid_blocks);
    }
#else
    p.ph_lo = 0; p.ph_hi = N_PHASES;
    void* args[] = {&p};
    hipError_t e = hipLaunchCooperativeKernel((const void*)fwd_megakernel, dim3(grid_blocks), dim3(512), args, LDS_BYTES, stream);
    if (e != hipSuccess) fprintf(stderr, "cooperative launch failed: %s (grid %d)\n", hipGetErrorString(e), grid_blocks);
#endif
}
```

```cpp
#include <hip/hip_runtime.h>
#include <hip/hip_cooperative_groups.h>
#include <cstdio>
namespace cg = cooperative_groups;

#define LAS __attribute__((address_space(3)))
typedef unsigned short bf16_t;
typedef short bf16x8 __attribute__((ext_vector_type(8)));
typedef float f32x4 __attribute__((ext_vector_type(4)));
typedef short bf16x4 __attribute__((ext_vector_type(4)));
typedef unsigned u32x4 __attribute__((ext_vector_type(4)));
typedef unsigned u32x2 __attribute__((ext_vector_type(2)));

constexpr int T = 32768, DM = 1024, SEQ = 8192, FF = 2816;
constexpr float LOG2E = 1.4426950408889634f;
constexpr size_t MBY = 1u << 20;
constexpr size_t WS_PART = 0;
constexpr size_t WS_BAR = 10 * MBY + 512 * 1024;
constexpr size_t WS_KMAX = 10 * MBY + 768 * 1024;
constexpr size_t WS_CBIAS = 11 * MBY;
constexpr size_t WS_WIN = 12 * MBY;
constexpr size_t WS_WOUT = 18 * MBY;
constexpr size_t WS_WGU0 = 20 * MBY;
constexpr size_t WS_WGU1 = 31 * MBY;
constexpr size_t WS_WDN0 = 42 * MBY;
constexpr size_t WS_WDN1 = 48 * MBY;
constexpr size_t WS_WKVQG = 54 * MBY;
constexpr size_t WS_WC1 = 60 * MBY;
constexpr size_t WS_WO = 62 * MBY;
constexpr size_t WS_WC2 = 64 * MBY;
constexpr size_t WS_HB = 65 * MBY;
constexpr size_t WS_HRES = 129 * MBY;
constexpr size_t WS_R = 257 * MBY;
constexpr size_t WS_CV = WS_R, WS_BG = WS_R + 64 * MBY, WS_U = WS_R + 128 * MBY;
constexpr size_t WS_HID = WS_R;
constexpr size_t WS_CMPRAW = WS_R;
constexpr size_t WS_KSLC = WS_R + 33 * MBY, WS_VSLC = WS_R + 49 * MBY, WS_KWIN = WS_R + 65 * MBY, WS_VWIN = WS_R + 81 * MBY;
constexpr size_t WS_Q = WS_R + 97 * MBY;
constexpr size_t WS_GATES = WS_R + 161 * MBY;
constexpr size_t WS_CHID = WS_R + 168 * MBY;
constexpr size_t WS_KCMP = WS_R + 176 * MBY;
constexpr size_t WS_VCMP = WS_R + 177 * MBY;
constexpr size_t WS_O = WS_R + 178 * MBY;
constexpr int LDS_BYTES = 155648;

struct Params { const float* in[20]; float* out; unsigned char* ws; int ph_lo, ph_hi; };

typedef float f32x2_t __attribute__((ext_vector_type(2)));
typedef __bf16 bf16x2_t __attribute__((ext_vector_type(2)));
__device__ __forceinline__ unsigned cvt_pk_bf16(float lo, float hi) { const f32x2_t v = {lo, hi}; const bf16x2_t b = __builtin_convertvector(v, bf16x2_t); return __builtin_bit_cast(unsigned, b); }
__device__ __forceinline__ bf16_t f2bf_sw(float f) { return (bf16_t)(cvt_pk_bf16(f, f) & 0xffffu); }
__device__ __forceinline__ float bf_lo(unsigned w) { return __uint_as_float(w << 16); }
__device__ __forceinline__ float bf_hi(unsigned w) { return __uint_as_float(w & 0xffff0000u); }
__device__ __forceinline__ u32x4 pack8(const f32x4 a, const f32x4 b) { u32x4 w; w.x = cvt_pk_bf16(a[0], a[1]); w.y = cvt_pk_bf16(a[2], a[3]); w.z = cvt_pk_bf16(b[0], b[1]); w.w = cvt_pk_bf16(b[2], b[3]); return w; }
__device__ __forceinline__ float row_rstd(const float* part, int r) {
    const f32x4* p = (const f32x4*)(part + (size_t)r * 16);
    const f32x4 s = (p[0] + p[1]) + (p[2] + p[3]);
    return rsqrtf(((s[0] + s[1]) + (s[2] + s[3])) * (1.0f / 1024.0f) + 1e-5f);
}
__device__ __forceinline__ float xsum_16_32(float x) { x += __shfl_xor(x, 16); x += __shfl_xor(x, 32); return x; }
__device__ __forceinline__ float xmax_16_32(float x) { x = fmaxf(x, __shfl_xor(x, 16)); x = fmaxf(x, __shfl_xor(x, 32)); return x; }
__device__ __forceinline__ void rows_rstd(const float* part, int row0, int fq, float (&rs)[2][4]) {
    f32x4 q[2][4];
#pragma unroll
    for (int ai = 0; ai < 2; ++ai)
#pragma unroll
        for (int m = 0; m < 4; ++m) q[ai][m] = ((const f32x4*)(part + (size_t)(row0 + ai * 128 + m * 16) * 16))[fq];
#pragma unroll
    for (int ai = 0; ai < 2; ++ai)
#pragma unroll
        for (int m = 0; m < 4; ++m) {
            float t = (q[ai][m][0] + q[ai][m][1]) + (q[ai][m][2] + q[ai][m][3]);
            t = xsum_16_32(t);
            rs[ai][m] = rsqrtf(t * (1.0f / 1024.0f) + 1e-5f);
        }
}
__device__ __forceinline__ float fast_rcp(float x) { return __builtin_amdgcn_rcpf(x); }
__device__ __forceinline__ float sigmoid_f(float g) { return fast_rcp(1.0f + __builtin_amdgcn_exp2f(g * -LOG2E)); }
__device__ __forceinline__ float silu_f(float g) { return g * sigmoid_f(g); }

namespace pg8 {
constexpr int BM = 256, BK = 64, HALF = 128, HTB = HALF * BK * 2, NXCD = 8, WGM = 8;
__device__ __forceinline__ int lds_byte(int r, int c) { const int st = (r >> 4) * 2 + (c >> 5), rr = r & 15, cc = c & 31, ob = rr * 64 + cc * 2; return st * 1024 + (ob ^ (((ob >> 9) & 1) << 5)); }
__device__ __forceinline__ void stage_rc(int b, int& R, int& C) { const int st = b / 1024, sb = b % 1024, swz = sb ^ (((sb >> 9) & 1) << 5); R = (st >> 1) * 16 + swz / 64; C = (st & 1) * 32 + (swz % 64) / 2; }
__device__ __forceinline__ int perm32(int rho) { const int n = rho >> 4, i = rho & 15; return 8 * (i >> 2) + 4 * n + (i & 3); }
struct Unit { int pm, pn, ar; };
struct Gemm { const bf16_t* A; const bf16_t* Bt; int lda, K; };
struct StaticOrder {
    int nM, nN, nwg, G, c;
    __device__ void init(int M, int N, int G_, int c_) { nM = M / BM; nN = N / BM; nwg = nM * nN; G = G_; c = c_; }
    __device__ bool next(int i, Unit& u) const {
        const long L = (long)i * G + c; if (L >= nwg) return false;
        int wgid = (int)L; { const int q = nwg / NXCD, r = nwg % NXCD, xcd = wgid % NXCD, off = wgid / NXCD; wgid = (xcd < r ? xcd * (q + 1) : r * (q + 1) + (xcd - r) * q) + off; }
        const int nig = WGM * nN, gid = wgid / nig, fm = gid * WGM, gsz = (nM - fm) < WGM ? (nM - fm) : WGM;
        u.pm = fm + ((wgid % nig) % gsz); u.pn = (wgid % nig) / gsz; u.ar = 0; return true;
    }
};
struct CmpOrder {
    int G, c;
    __device__ bool next(int i, Unit& u) const { const int L = i * G + c; if (L >= 128) return false; u.pm = L >> 1; u.ar = L & 1; u.pn = (u.pm >> 5) * 2 + (L & 1); return true; }
};

struct GateOrder {
    int G, c;
    __device__ bool next(int i, Unit& u) const { const int L = i * G + c; if (L >= 128) return false; u.pm = L; u.pn = 10; u.ar = 0; return true; }
};
template <class Epi, class Sched>
__device__ __forceinline__ void gemm_phase(LAS unsigned char* lds, const Gemm g, const Sched& S, const Epi& E) {
    const int tid = threadIdx.x, wid = __builtin_amdgcn_readfirstlane(tid >> 6), lane = tid & 63, wr = wid >> 2, wc = wid & 3, fr = lane & 15, fq = lane >> 4;
    const int K = g.K, nt = K / BK;
    unsigned voffA[2], voffB[2];
#pragma unroll
    for (int i = 0; i < 2; ++i) { int R, C; stage_rc(tid * 16 + i * 8192, R, C); const int Rb = (R & ~31) + perm32(R & 31);
        voffA[i] = (unsigned)(R * g.lda + C) * 2u; voffB[i] = (unsigned)(Rb * K + C) * 2u; }
    const size_t kstep = (size_t)(BK * 2);
    const size_t hstepA = (size_t)HALF * g.lda * 2, hstepB = (size_t)HALF * K * 2;
    const size_t tstepA = 2 * hstepA, tstepB = 2 * hstepB;
    const unsigned ldsw = (unsigned)wid * 1024u;
    const int aoff = lds_byte(wr * 64 + fr, fq * 8), boff = lds_byte(wc * 32 + fr, fq * 8);
#define PG8_SA(b, h) (((b) * 2 + (h)) * HTB)
#define PG8_SB(b, h) ((4 + (b) * 2 + (h)) * HTB)
#define PG8_STAGE(bufoff, gbase, voff) do { _Pragma("unroll") for (int _i = 0; _i < 2; ++_i) \
        __builtin_amdgcn_global_load_lds((const unsigned*)((const char*)(gbase) + (voff)[_i]), (LAS unsigned*)(lds + (bufoff) + ldsw + _i * 8192), 16, 0, 0); } while (0)
#define PG8_LDA(dst, b, h) do { _Pragma("unroll") for (int m = 0; m < 4; ++m) _Pragma("unroll") for (int k = 0; k < 2; ++k) dst[m][k] = *(const LAS bf16x8*)(lds + PG8_SA(b, h) + aoff + m * 2048 + k * 1024); } while (0)
#define PG8_LDB(dst, b, h) do { _Pragma("unroll") for (int n = 0; n < 2; ++n) _Pragma("unroll") for (int k = 0; k < 2; ++k) dst[n][k] = *(const LAS bf16x8*)(lds + PG8_SB(b, h) + boff + n * 2048 + k * 1024); } while (0)
#define PG8_MMA(ai, bj, At, Bt) do { __builtin_amdgcn_s_setprio(1); _Pragma("unroll") for (int m = 0; m < 4; ++m) _Pragma("unroll") for (int n = 0; n < 2; ++n) _Pragma("unroll") for (int k = 0; k < 2; ++k) \
        acc[ai][bj][m][n] = __builtin_amdgcn_mfma_f32_16x16x32_bf16(Bt[n][k], At[m][k], acc[ai][bj][m][n], 0, 0, 0); __builtin_amdgcn_s_setprio(0); } while (0)
#define PG8_WAIT_V(n) asm volatile("s_waitcnt vmcnt(" #n ")" ::: "memory")
#define PG8_WAIT_L(n) asm volatile("s_waitcnt lgkmcnt(" #n ")" ::: "memory")
#define PG8_BAR __builtin_amdgcn_s_barrier()
#define PG8_SCHED __builtin_amdgcn_sched_barrier(0)
    Unit cur, nxt; int ui = 0;
    if (!S.next(0, cur)) return;
    f32x4 acc[2][2][4][2];
#pragma unroll
    for (int a = 0; a < 2; ++a)
#pragma unroll
        for (int b = 0; b < 2; ++b)
#pragma unroll
            for (int m = 0; m < 4; ++m)
#pragma unroll
                for (int n = 0; n < 2; ++n) acc[a][b][m][n] = (f32x4){0.f, 0.f, 0.f, 0.f};
    bf16x8 At[4][2], B0[2][2], B1[2][2];
    const char* cA = (const char*)g.A + (size_t)cur.pm * tstepA + (size_t)cur.ar * g.lda * 2; const char* cB = (const char*)g.Bt + (size_t)cur.pn * tstepB;
    LAS unsigned char* rsimg = lds + 131072 + wr * 8192;
    if constexpr (Epi::NEEDS_RS) E.pre(cur, rsimg, wid, wr, lane);
    PG8_STAGE(PG8_SB(0, 0), cB, voffB); PG8_STAGE(PG8_SA(0, 0), cA, voffA); PG8_STAGE(PG8_SB(0, 1), cB + hstepB, voffB); PG8_STAGE(PG8_SA(0, 1), cA + hstepA, voffA);
    if (wr == 1) PG8_BAR;
    PG8_WAIT_V(4); PG8_BAR;
    PG8_STAGE(PG8_SB(1, 0), cB + kstep, voffB); PG8_STAGE(PG8_SA(1, 0), cA + kstep, voffA); PG8_STAGE(PG8_SB(1, 1), cB + hstepB + kstep, voffB);
    PG8_WAIT_V(6); PG8_BAR;
    for (;;) {
        const bool has_next = S.next(ui + 1, nxt);
        const char* nA = has_next ? (const char*)g.A + (size_t)nxt.pm * tstepA + (size_t)nxt.ar * g.lda * 2 : cA; const char* nB = has_next ? (const char*)g.Bt + (size_t)nxt.pn * tstepB : cB;
        for (int t = 0; t < nt; t += 2) {
            const bool last = (t == nt - 2);
            const char* a1 = cA + (size_t)(t + 1) * kstep;
            const char* a2 = last ? nA : cA + (size_t)(t + 2) * kstep; const char* b2 = last ? nB : cB + (size_t)(t + 2) * kstep;
            const char* a3 = a2 + kstep; const char* b3 = b2 + kstep;
            PG8_LDB(B0, 0, 0); PG8_SCHED; PG8_LDA(At, 0, 0); PG8_STAGE(PG8_SA(1, 1), a1 + hstepA, voffA);
            PG8_WAIT_L(8); PG8_BAR; PG8_WAIT_L(0); PG8_MMA(0, 0, At, B0); PG8_BAR; PG8_SCHED;
            PG8_LDB(B1, 0, 1); PG8_STAGE(PG8_SB(0, 0), b2, voffB);
            PG8_BAR; PG8_WAIT_L(0); PG8_MMA(0, 1, At, B1); PG8_BAR;
            PG8_LDA(At, 0, 1); PG8_STAGE(PG8_SA(0, 0), a2, voffA);
            PG8_BAR; PG8_WAIT_L(0); PG8_MMA(1, 0, At, B0); PG8_BAR; PG8_SCHED;
            PG8_STAGE(PG8_SB(0, 1), b2 + hstepB, voffB);
            PG8_WAIT_V(6); PG8_BAR; PG8_MMA(1, 1, At, B1); PG8_BAR;
            PG8_LDB(B0, 1, 0); PG8_SCHED; PG8_LDA(At, 1, 0); PG8_STAGE(PG8_SA(0, 1), a2 + hstepA, voffA);
            PG8_WAIT_L(8); PG8_BAR; PG8_WAIT_L(0); PG8_MMA(0, 0, At, B0); PG8_BAR; PG8_SCHED;
            PG8_LDB(B1, 1, 1); PG8_STAGE(PG8_SB(1, 0), b3, voffB);
            PG8_BAR; PG8_WAIT_L(0); PG8_MMA(0, 1, At, B1); PG8_BAR;
            PG8_LDA(At, 1, 1); PG8_STAGE(PG8_SA(1, 0), a3, voffA);
            PG8_BAR; PG8_WAIT_L(0); PG8_MMA(1, 0, At, B0); PG8_BAR; PG8_SCHED;
            PG8_STAGE(PG8_SB(1, 1), b3 + hstepB, voffB);
            PG8_WAIT_V(6); PG8_BAR; PG8_MMA(1, 1, At, B1); PG8_BAR;
        }
        if constexpr (Epi::NEEDS_RS) {
            float rsa[2][4];
            {
                f32x4 q[2][4];
#pragma unroll
                for (int ai = 0; ai < 2; ++ai)
#pragma unroll
                    for (int m = 0; m < 4; ++m) q[ai][m] = *(const LAS f32x4*)(rsimg + (ai * 4 + m) * 1024 + fq * 256 + fr * 16);
#pragma unroll
                for (int ai = 0; ai < 2; ++ai)
#pragma unroll
                    for (int m = 0; m < 4; ++m) { const float t4 = xsum_16_32((q[ai][m][0] + q[ai][m][1]) + (q[ai][m][2] + q[ai][m][3])); rsa[ai][m] = rsqrtf(t4 * (1.0f / 1024.0f) + 1e-5f); }
                asm volatile("s_waitcnt lgkmcnt(0)" ::: "memory"); PG8_BAR; asm volatile("" ::: "memory");
                if (has_next) E.pre(nxt, rsimg, wid, wr, lane);
            }
            E(acc, cur, wr, wc, fr, fq, rsa);
        } else E(acc, cur, wr, wc, fr, fq);
        if (!has_next) break;
#pragma unroll
        for (int a = 0; a < 2; ++a)
#pragma unroll
            for (int b = 0; b < 2; ++b)
#pragma unroll
                for (int m = 0; m < 4; ++m)
#pragma unroll
                    for (int n = 0; n < 2; ++n) acc[a][b][m][n] = (f32x4){0.f, 0.f, 0.f, 0.f};
        cur = nxt; cA = nA; cB = nB; ++ui;
    }
    PG8_WAIT_V(0);
    if (wr == 0) PG8_BAR;
    PG8_BAR;
#undef PG8_SA
#undef PG8_SB
#undef PG8_STAGE
#undef PG8_LDA
#undef PG8_LDB
#undef PG8_MMA
#undef PG8_WAIT_V
#undef PG8_WAIT_L
#undef PG8_BAR
#undef PG8_SCHED
}
}
using pg8::Unit;
typedef f32x4 AccT[2][2][4][2];

struct EpiWin {
    const float* part; bf16_t* cv; bf16_t* bg;
        static constexpr bool NEEDS_RS = true;
    __device__ __forceinline__ void pre(const Unit& u, LAS unsigned char* img, int wid, int wr, int lane) const {
#pragma unroll
        for (int k = 0; k < 2; ++k) {
            const int L = k * 4096 + (wid & 3) * 1024 + lane * 16, gq = L >> 10, c = (L >> 8) & 3, rr = (L >> 4) & 15, hl = gq * 16 + rr;
            const int row = u.pm * 256 + (hl >> 6) * 128 + wr * 64 + (hl & 63);
            __builtin_amdgcn_global_load_lds((const unsigned*)(part + (size_t)row * 16 + c * 4), (LAS unsigned*)(img + k * 4096 + (wid & 3) * 1024), 16, 0, 0);
        }
    }
    __device__ __forceinline__ void operator()(const AccT& acc, const Unit& u, int wr, int wc, int fr, int fq, const float (&rsa)[2][4]) const {
        const int row0 = u.pm * 256 + wr * 64 + fr, cbase = wc * 32 + 8 * fq;
#pragma unroll
        for (int ai = 0; ai < 2; ++ai)
#pragma unroll
            for (int m = 0; m < 4; ++m) {
                const int r = row0 + ai * 128 + m * 16; const float rs = rsa[ai][m];
                if (u.pn < 8) { const float rs2 = rs * rs;
                    *(u32x4*)(cv + (size_t)r * 1024 + u.pn * 128 + cbase) = pack8(acc[ai][0][m][0] * acc[ai][1][m][0] * rs2, acc[ai][0][m][1] * acc[ai][1][m][1] * rs2);
                } else {
#pragma unroll
                    for (int bj = 0; bj < 2; ++bj) *(u32x4*)(bg + (size_t)r * 1024 + (u.pn - 8) * 256 + bj * 128 + cbase) = pack8(acc[ai][bj][m][0] * rs, acc[ai][bj][m][1] * rs);
                }
            }
    }
};
struct EpiRes {
    static constexpr bool NEEDS_RS = false;
    const float* resid; float* hout; bf16_t* hb; float* part_out;
    __device__ __forceinline__ void operator()(const AccT& acc, const Unit& u, int wr, int wc, int fr, int fq) const {
        const int row0 = u.pm * 256 + wr * 64 + fr, cbase = wc * 32 + 8 * fq;
#pragma unroll
        for (int ai = 0; ai < 2; ++ai) {
          f32x4 rv[4][2][2];
#pragma unroll
          for (int m = 0; m < 4; ++m)
#pragma unroll
              for (int bj = 0; bj < 2; ++bj) { const size_t off = (size_t)(row0 + ai * 128 + m * 16) * 1024 + u.pn * 256 + bj * 128 + cbase;
                  rv[m][bj][0] = *(const f32x4*)(resid + off); rv[m][bj][1] = *(const f32x4*)(resid + off + 4); }
#pragma unroll
            for (int m = 0; m < 4; ++m) {
                const int r = row0 + ai * 128 + m * 16; float ss = 0.f;
#pragma unroll
                for (int bj = 0; bj < 2; ++bj) {
                    const size_t off = (size_t)r * 1024 + u.pn * 256 + bj * 128 + cbase;
                    const f32x4 v0 = rv[m][bj][0] + acc[ai][bj][m][0], v1 = rv[m][bj][1] + acc[ai][bj][m][1];
                    *(f32x4*)(hout + off) = v0; *(f32x4*)(hout + off + 4) = v1;
                    if (hb) *(u32x4*)(hb + off) = pack8(v0, v1);
                    ss += (v0[0] * v0[0] + v0[1] * v0[1]) + (v0[2] * v0[2] + v0[3] * v0[3]) + (v1[0] * v1[0] + v1[1] * v1[1]) + (v1[2] * v1[2] + v1[3] * v1[3]);
                }
                ss = xsum_16_32(ss);
                if (fq == 0) part_out[(size_t)r * 16 + u.pn * 4 + wc] = ss;
            }
        }
    }
};
struct EpiResB {
    static constexpr bool NEEDS_RS = false;
    bf16_t* hb; float* part_out;
    __device__ __forceinline__ void operator()(const AccT& acc, const Unit& u, int wr, int wc, int fr, int fq) const {
        const int row0 = u.pm * 256 + wr * 64 + fr, cbase = wc * 32 + 8 * fq;
#pragma unroll
        for (int ai = 0; ai < 2; ++ai) {
            u32x4 rv[4][2];
#pragma unroll
            for (int m = 0; m < 4; ++m)
#pragma unroll
                for (int bj = 0; bj < 2; ++bj) rv[m][bj] = *(const u32x4*)(hb + (size_t)(row0 + ai * 128 + m * 16) * 1024 + u.pn * 256 + bj * 128 + cbase);
#pragma unroll
            for (int m = 0; m < 4; ++m) {
                const int r = row0 + ai * 128 + m * 16; float ss = 0.f;
#pragma unroll
                for (int bj = 0; bj < 2; ++bj) {
                    const u32x4 w = rv[m][bj];
                    const f32x4 v0 = (f32x4){bf_lo(w.x), bf_hi(w.x), bf_lo(w.y), bf_hi(w.y)} + acc[ai][bj][m][0];
                    const f32x4 v1 = (f32x4){bf_lo(w.z), bf_hi(w.z), bf_lo(w.w), bf_hi(w.w)} + acc[ai][bj][m][1];
                    *(u32x4*)(hb + (size_t)r * 1024 + u.pn * 256 + bj * 128 + cbase) = pack8(v0, v1);
                    ss += (v0[0] * v0[0] + v0[1] * v0[1]) + (v0[2] * v0[2] + v0[3] * v0[3]) + (v1[0] * v1[0] + v1[1] * v1[1]) + (v1[2] * v1[2] + v1[3] * v1[3]);
                }
                ss = xsum_16_32(ss);
                if (fq == 0) part_out[(size_t)r * 16 + u.pn * 4 + wc] = ss;
            }
        }
    }
};
struct EpiGu {
    const float* part; bf16_t* hid;
        static constexpr bool NEEDS_RS = true;
    __device__ __forceinline__ void pre(const Unit& u, LAS unsigned char* img, int wid, int wr, int lane) const {
#pragma unroll
        for (int k = 0; k < 2; ++k) {
            const int L = k * 4096 + (wid & 3) * 1024 + lane * 16, gq = L >> 10, c = (L >> 8) & 3, rr = (L >> 4) & 15, hl = gq * 16 + rr;
            const int row = u.pm * 256 + (hl >> 6) * 128 + wr * 64 + (hl & 63);
            __builtin_amdgcn_global_load_lds((const unsigned*)(part + (size_t)row * 16 + c * 4), (LAS unsigned*)(img + k * 4096 + (wid & 3) * 1024), 16, 0, 0);
        }
    }
    __device__ __forceinline__ void operator()(const AccT& acc, const Unit& u, int wr, int wc, int fr, int fq, const float (&rsa)[2][4]) const {
        const int row0 = u.pm * 256 + wr * 64 + fr, cbase = wc * 32 + 8 * fq;
#pragma unroll
        for (int ai = 0; ai < 2; ++ai)
#pragma unroll
            for (int m = 0; m < 4; ++m) {
                const int r = row0 + ai * 128 + m * 16; const float rs = rsa[ai][m];
                f32x4 o[2];
#pragma unroll
                for (int n = 0; n < 2; ++n)
#pragma unroll
                    for (int j = 0; j < 4; ++j) { const float gg = acc[ai][0][m][n][j] * rs, uu = acc[ai][1][m][n][j] * rs; o[n][j] = silu_f(gg) * uu; }
                *(u32x4*)(hid + (size_t)r * FF + u.pn * 128 + cbase) = pack8(o[0], o[1]);
            }
    }
};
struct EpiKvqg {
    const float* part; unsigned char* ws;
        static constexpr bool NEEDS_RS = true;
    __device__ __forceinline__ void pre(const Unit& u, LAS unsigned char* img, int wid, int wr, int lane) const {
#pragma unroll
        for (int k = 0; k < 2; ++k) {
            const int L = k * 4096 + (wid & 3) * 1024 + lane * 16, gq = L >> 10, c = (L >> 8) & 3, rr = (L >> 4) & 15, hl = gq * 16 + rr;
            const int row = u.pm * 256 + (hl >> 6) * 128 + wr * 64 + (hl & 63);
            __builtin_amdgcn_global_load_lds((const unsigned*)(part + (size_t)row * 16 + c * 4), (LAS unsigned*)(img + k * 4096 + (wid & 3) * 1024), 16, 0, 0);
        }
    }
    __device__ __forceinline__ void operator()(const AccT& acc, const Unit& u, int wr, int wc, int fr, int fq, const float (&rsa)[2][4]) const {
        const int row0 = u.pm * 256 + wr * 64 + fr, cbase = wc * 32 + 8 * fq;
#pragma unroll
        for (int ai = 0; ai < 2; ++ai)
#pragma unroll
            for (int m = 0; m < 4; ++m) {
                const int r = row0 + ai * 128 + m * 16; const float rs = rsa[ai][m];
                const int b = r >> 13, s = r & 8191;
#pragma unroll
                for (int bj = 0; bj < 2; ++bj) {
                    const int col = bj * 128 + cbase;
                    const f32x4 v0 = acc[ai][bj][m][0] * rs, v1 = acc[ai][bj][m][1] * rs;
                    if (u.pn < 6) {
                        const int gi = col >> 6, d = col & 63, bgi = b * 4 + gi;
                        if (u.pn < 2) { *(u32x4*)((bf16_t*)(ws + WS_CMPRAW) + ((size_t)(u.pn * 16 + bgi) * SEQ + s) * 64 + d) = pack8(v0, v1); }
                        else if (u.pn == 2 || u.pn == 4) { *(u32x4*)((bf16_t*)(ws + (u.pn == 2 ? WS_KSLC : WS_KWIN)) + ((size_t)bgi * SEQ + s) * 64 + d) = pack8(v0, v1); }
                        else { bf16_t* vt = (bf16_t*)(ws + (u.pn == 3 ? WS_VSLC : WS_VWIN)) + ((size_t)(bgi * 128 + (s >> 6)) * 64 + d) * 64 + (s & 63);
                            const u32x4 w = pack8(v0, v1);
                            vt[0 * 64] = (bf16_t)(w.x & 0xffff); vt[1 * 64] = (bf16_t)(w.x >> 16); vt[2 * 64] = (bf16_t)(w.y & 0xffff); vt[3 * 64] = (bf16_t)(w.y >> 16);
                            vt[4 * 64] = (bf16_t)(w.z & 0xffff); vt[5 * 64] = (bf16_t)(w.z >> 16); vt[6 * 64] = (bf16_t)(w.w & 0xffff); vt[7 * 64] = (bf16_t)(w.w >> 16); }
                    } else if (u.pn < 10) {
                        const float qs = 0.125f * LOG2E;
                        *(u32x4*)((bf16_t*)(ws + WS_Q) + (size_t)r * 1024 + (u.pn - 6) * 256 + col) = pack8(v0 * qs, v1 * qs);
                    } else {
                        if (col < 48) { float* gp = (float*)(ws + WS_GATES) + (size_t)r * 48 + col;
                            f32x4 a, c2;
#pragma unroll
                            for (int j = 0; j < 4; ++j) { a[j] = sigmoid_f(v0[j]); c2[j] = sigmoid_f(v1[j]); }
                            *(f32x4*)gp = a; *(f32x4*)(gp + 4) = c2; }
                    }
                }
            }
    }
};
struct EpiCmp {
    static constexpr bool NEEDS_RS = false;
    bf16_t* pbuf;
    __device__ __forceinline__ void operator()(const AccT& acc, const Unit& u, int wr, int wc, int fr, int fq) const {
        const int row0 = u.pm * 256 + wr * 64 + fr, cbase = wc * 32 + 8 * fq;
        bf16_t* base = pbuf + (size_t)(u.pn & 1) * 16384 * 256;
#pragma unroll
        for (int ai = 0; ai < 2; ++ai)
#pragma unroll
            for (int m = 0; m < 4; ++m) {
                const int r = row0 + ai * 128 + m * 16;
#pragma unroll
                for (int bj = 0; bj < 2; ++bj) *(u32x4*)(base + (size_t)r * 256 + bj * 128 + cbase) = pack8(acc[ai][bj][m][0], acc[ai][bj][m][1]);
            }
    }
};

__device__ __forceinline__ void transpose_item(const float* W, int K, int Nsrc, bf16_t* dst, int kind, const float* gain, int item, LAS float* scr, int nN64) {
    const int tid = threadIdx.x;
    const int kb = item / nN64, nb = item % nN64, k0 = kb * 64, nd0 = nb * 64;
    int ns0 = nd0;
    if (kind == 1) { if (nd0 < 2048) { const int pn = nd0 >> 8, half = (nd0 >> 7) & 1, c = nd0 & 127; ns0 = 1024 + half * 1024 + pn * 128 + c; } else ns0 = nd0 - 2048; }
    else if (kind == 2) { const int pn = nd0 >> 8, half = (nd0 >> 7) & 1, c = nd0 & 127; ns0 = half * FF + pn * 128 + c; }
    const int kk = tid >> 4, n4 = (tid & 15) * 4;
#pragma unroll
    for (int i = 0; i < 2; ++i) {
        const int k = k0 + kk + 32 * i;
        f32x4 v = (f32x4){0.f, 0.f, 0.f, 0.f};
        if (ns0 + n4 < Nsrc) v = *(const f32x4*)(W + (size_t)k * Nsrc + ns0 + n4);
        if (gain) v = v * gain[k];
        LAS float* sp = scr + (kk + 32 * i) * 65 + n4;
        sp[0] = v[0]; sp[1] = v[1]; sp[2] = v[2]; sp[3] = v[3];
    }
    __syncthreads();
    const int n = tid >> 3, kc = (tid & 7) * 8;
    const LAS float* s = scr + kc * 65 + n;
    u32x4 o; o.x = cvt_pk_bf16(s[0], s[65]); o.y = cvt_pk_bf16(s[2 * 65], s[3 * 65]); o.z = cvt_pk_bf16(s[4 * 65], s[5 * 65]); o.w = cvt_pk_bf16(s[6 * 65], s[7 * 65]);
    *(u32x4*)(dst + (size_t)(nd0 + n) * K + k0 + kc) = o;
    __syncthreads();
}
__device__ __forceinline__ void prep_phase(const Params& p, LAS unsigned char* lds) {
    LAS float* scr = (LAS float*)lds;
    unsigned char* ws = p.ws;
    const int G = gridDim.x, bx = blockIdx.x, tid = threadIdx.x, lane = tid & 63, wv = tid >> 6;
    constexpr int NW = 15;
    const float* srcs[NW] = {p.in[2], p.in[4], p.in[17], p.in[17] + (size_t)1024 * 5632, p.in[18], p.in[18] + (size_t)FF * 1024, p.in[6], p.in[14], p.in[8], p.in[11], p.in[15], p.in[9], p.in[12],
                             p.in[8] + (size_t)1024 * 256, p.in[11] + (size_t)1024 * 256};
    const int Ks[NW] = {1024, 1024, 1024, 1024, FF, FF, 1024, 1024, 1024, 1024, 1024, 256, 256, 1024, 1024};
    const int Nsrcs[NW] = {3072, 1024, 5632, 5632, 1024, 1024, 1536, 1072, 256, 256, 1024, 64, 64, 256, 256};
    const int Ndsts[NW] = {3072, 1024, 5632, 5632, 1024, 1024, 1536, 1280, 256, 256, 1024, 64, 64, 256, 256};
    const size_t dsts[NW] = {WS_WIN, WS_WOUT, WS_WGU0, WS_WGU1, WS_WDN0, WS_WDN1, WS_WKVQG, WS_WKVQG + (size_t)1536 * 1024 * 2, WS_WC1, WS_WC1 + (size_t)2 * 256 * 1024 * 2, WS_WO, WS_WC2, WS_WC2 + 64 * 256 * 2,
                             WS_WC1 + (size_t)1 * 256 * 1024 * 2, WS_WC1 + (size_t)3 * 256 * 1024 * 2};
    const int kinds[NW] = {1, 0, 2, 2, 0, 0, 0, 0, 0, 0, 0, 0, 0, 0, 0};
    const float* gains[NW] = {p.in[1], nullptr, p.in[16], p.in[16] + 1024, nullptr, nullptr, p.in[5], p.in[13], nullptr, nullptr, nullptr, nullptr, nullptr, nullptr, nullptr};
    int base = 0;
#pragma unroll
    for (int wi = 0; wi < NW; ++wi) {
        const int nN64 = Ndsts[wi] / 64, nitems = (Ks[wi] / 64) * nN64;
        int first = (bx - base % G + G) % G;
        for (int it = first; it < nitems; it += G) transpose_item(srcs[wi], Ks[wi], Nsrcs[wi], (bf16_t*)(ws + dsts[wi]), kinds[wi], gains[wi], it, scr, nN64);
        base += nitems;
    }
    {
        const float* x = p.in[0]; bf16_t* hb = (bf16_t*)(ws + WS_HB); float* part = (float*)(ws + WS_PART);
        for (int r = bx * 8 + wv; r < T; r += G * 8) {
            const f32x4* xr = (const f32x4*)(x + (size_t)r * 1024);
            float ss = 0.f;
#pragma unroll
            for (int j = 0; j < 2; ++j) {
                const f32x4 a = __builtin_nontemporal_load(xr + j * 128 + lane * 2), b = __builtin_nontemporal_load(xr + j * 128 + lane * 2 + 1);
                ss += (a[0] * a[0] + a[1] * a[1]) + (a[2] * a[2] + a[3] * a[3]) + (b[0] * b[0] + b[1] * b[1]) + (b[2] * b[2] + b[3] * b[3]);
                *(u32x4*)(hb + (size_t)r * 1024 + j * 512 + lane * 8) = pack8(a, b);
            }
#pragma unroll
            for (int o = 1; o < 64; o <<= 1) ss += __shfl_xor(ss, o);
            if (lane < 16) part[(size_t)r * 16 + lane] = (lane == 0) ? ss : 0.f;
        }
    }
    if (bx == 0) { unsigned* bw = (unsigned*)(ws + WS_BAR); for (int i = tid; i < 3456; i += 512) __hip_atomic_store(bw + i, 0u, __ATOMIC_RELAXED, __HIP_MEMORY_SCOPE_AGENT); }
    if (bx == 1 && tid < 17) __hip_atomic_store((unsigned*)(ws + WS_KMAX) + tid, 0u, __ATOMIC_RELAXED, __HIP_MEMORY_SCOPE_AGENT);
    if (bx < 2 && tid < 256) {
        const float* pe = p.in[bx == 0 ? 7 : 10]; const float* w1 = p.in[bx == 0 ? 8 : 11];
        float a = 0.f;
        for (int i = 0; i < 2048; ++i) a += pe[i] * w1[(size_t)i * 256 + tid];
        ((float*)(ws + WS_CBIAS))[bx * 256 + tid] = a;
    }
}

__device__ __forceinline__ void conv_phase(const Params& p) {
    unsigned char* ws = p.ws;
    const bf16_t* cv = (const bf16_t*)(ws + WS_CV); const bf16_t* bg = (const bf16_t*)(ws + WS_BG); bf16_t* uo = (bf16_t*)(ws + WS_U);
    const float* cw = p.in[3];
    const size_t total = (size_t)T * 128, stride = (size_t)gridDim.x * 512;
    for (size_t idx = (size_t)blockIdx.x * 512 + threadIdx.x; idx < total; idx += stride) {
        const int t = (int)(idx >> 7), c8 = (int)(idx & 127) * 8, s = t & 8191;
        const u32x4 z = (u32x4){0u, 0u, 0u, 0u};
        const u32x4 x2 = *(const u32x4*)(cv + (size_t)t * 1024 + c8);
        const u32x4 x1 = s >= 1 ? *(const u32x4*)(cv + (size_t)(t - 1) * 1024 + c8) : z;
        const u32x4 x0 = s >= 2 ? *(const u32x4*)(cv + (size_t)(t - 2) * 1024 + c8) : z;
        const u32x4 bb = *(const u32x4*)(bg + (size_t)t * 1024 + c8);
        const f32x4 w0a = *(const f32x4*)(cw + c8), w0b = *(const f32x4*)(cw + c8 + 4);
        const f32x4 w1a = *(const f32x4*)(cw + 1024 + c8), w1b = *(const f32x4*)(cw + 1024 + c8 + 4);
        const f32x4 w2a = *(const f32x4*)(cw + 2048 + c8), w2b = *(const f32x4*)(cw + 2048 + c8 + 4);
        f32x4 oa, ob;
#pragma unroll
        for (int j = 0; j < 2; ++j) {
            oa[2 * j] = bf_lo(bb[j]) * (w0a[2 * j] * bf_lo(x0[j]) + w1a[2 * j] * bf_lo(x1[j]) + w2a[2 * j] * bf_lo(x2[j]));
            oa[2 * j + 1] = bf_hi(bb[j]) * (w0a[2 * j + 1] * bf_hi(x0[j]) + w1a[2 * j + 1] * bf_hi(x1[j]) + w2a[2 * j + 1] * bf_hi(x2[j]));
            ob[2 * j] = bf_lo(bb[2 + j]) * (w0b[2 * j] * bf_lo(x0[2 + j]) + w1b[2 * j] * bf_lo(x1[2 + j]) + w2b[2 * j] * bf_lo(x2[2 + j]));
            ob[2 * j + 1] = bf_hi(bb[2 + j]) * (w0b[2 * j + 1] * bf_hi(x0[2 + j]) + w1b[2 * j + 1] * bf_hi(x1[2 + j]) + w2b[2 * j + 1] * bf_hi(x2[2 + j]));
        }
        *(u32x4*)(uo + (size_t)t * 1024 + c8) = pack8(oa, ob);
    }
}

__device__ __forceinline__ void cmp2_phase(const Params& p) {
    unsigned char* ws = p.ws;
    const bf16_t* pb0 = (const bf16_t*)(ws + WS_O); const bf16_t* pb1 = pb0 + (size_t)16384 * 256; const float* cbias = (const float*)(ws + WS_CBIAS);
    const bf16_t* w2t = (const bf16_t*)(ws + WS_WC2);
    bf16_t* kcmp = (bf16_t*)(ws + WS_KCMP); bf16_t* vcmp = (bf16_t*)(ws + WS_VCMP);
    const int tid = threadIdx.x, lane = tid & 63, wv = tid >> 6, i16 = lane & 15, slab = lane >> 4;
    for (int un = blockIdx.x; un < 256; un += gridDim.x) {
        const int R0 = un * 64, set = R0 >> 13;
        const int rt = wv >> 1;
        const size_t aoff = (size_t)(R0 + 16 * rt + i16) * 256 + 8 * slab;
        u32x4 pw0[8], pw1[8]; f32x4 pba[8], pbb[8];
#pragma unroll
        for (int ks = 0; ks < 8; ++ks) { pw0[ks] = *(const u32x4*)(pb0 + aoff + 32 * ks); pw1[ks] = *(const u32x4*)(pb1 + aoff + 32 * ks);
            pba[ks] = *(const f32x4*)(cbias + set * 256 + 32 * ks + 8 * slab); pbb[ks] = *(const f32x4*)(cbias + set * 256 + 32 * ks + 8 * slab + 4); }
        f32x4 c[2] = {(f32x4){0.f, 0.f, 0.f, 0.f}, (f32x4){0.f, 0.f, 0.f, 0.f}};
        float amax = 0.f;
#pragma unroll
        for (int ks = 0; ks < 8; ++ks) {
            const u32x4 w0 = pw0[ks], w1 = pw1[ks]; const f32x4 ba = pba[ks], bb = pbb[ks];
            f32x4 h0, h1;
            h0[0] = silu_f(bf_lo(w0.x) + bf_lo(w1.x) + ba[0]); h0[1] = silu_f(bf_hi(w0.x) + bf_hi(w1.x) + ba[1]);
            h0[2] = silu_f(bf_lo(w0.y) + bf_lo(w1.y) + ba[2]); h0[3] = silu_f(bf_hi(w0.y) + bf_hi(w1.y) + ba[3]);
            h1[0] = silu_f(bf_lo(w0.z) + bf_lo(w1.z) + bb[0]); h1[1] = silu_f(bf_hi(w0.z) + bf_hi(w1.z) + bb[1]);
            h1[2] = silu_f(bf_lo(w0.w) + bf_lo(w1.w) + bb[2]); h1[3] = silu_f(bf_hi(w0.w) + bf_hi(w1.w) + bb[3]);
            const u32x4 aw = pack8(h0, h1);
            const bf16x8 a = *(const bf16x8*)&aw;
#pragma unroll
            for (int cc = 0; cc < 2; ++cc) {
                const int ct = (wv & 1) * 2 + cc;
                const bf16x8 b = *(const bf16x8*)(w2t + (size_t)set * 64 * 256 + (size_t)(16 * ct + i16) * 256 + 32 * ks + 8 * slab);
                c[cc] = __builtin_amdgcn_mfma_f32_16x16x32_bf16(a, b, c[cc], 0, 0, 0);
            }
        }
#pragma unroll
        for (int cc = 0; cc < 2; ++cc) {
            const int n = 16 * ((wv & 1) * 2 + cc) + i16;
#pragma unroll
            for (int r = 0; r < 4; ++r) {
                const int R = R0 + 16 * rt + 4 * slab + r, rr = R & 8191, bgi = rr >> 9, nn = rr & 511;
                const float v = (nn == 511) ? 0.f : c[cc][r];
                const bf16_t hv = f2bf_sw(v);
                if (set == 0) kcmp[((size_t)bgi * 512 + nn) * 64 + n] = hv;
                else vcmp[(((size_t)bgi * 8 + (nn >> 6)) * 64 + n) * 64 + (nn & 63)] = hv;
                amax = fmaxf(amax, fabsf(v));
            }
        }
        if (set == 0) {
#pragma unroll
            for (int o = 1; o < 64; o <<= 1) amax = fmaxf(amax, __shfl_xor(amax, o));
            if (lane == 0) __hip_atomic_fetch_max((unsigned*)(ws + WS_KMAX) + ((R0 & 8191) >> 9), __float_as_uint(amax), __ATOMIC_RELAXED, __HIP_MEMORY_SCOPE_AGENT);
        }
    }
}

constexpr int KP = 72;
constexpr int IMP_P = 132;
constexpr int A_K = 0, A_V = 24576, A_IMP = 49152, A_WUN = A_IMP + 64 * IMP_P * 4, A_TL = A_WUN + 128, A_SEL = A_TL + 512, A_OFIN = 86016;

template <bool MASK, int KIND>
__device__ __forceinline__ void attn_tile(const LAS bf16_t* Kb, const LAS bf16_t* Vb, const bf16x8 (&qf)[2][2], f32x4 (&O)[2][4], float (&m)[2], float (&l)[2],
                                          const float (&lb)[2], const float (&slope2)[2], const float skmul, int lo, int hi, int col, int slab, LAS float* imp_row, int jbase) {
    const int sw = (col >> 1) & 7;
    constexpr float LAZY_THR = 12.0f;
    f32x4 sc[2][4];
    float mref[2];
#pragma unroll
    for (int ct = 0; ct < 2; ++ct) {
        const float skv = slope2[ct] * skmul;
        mref[ct] = (m[ct] < -1e19f) ? 0.f : m[ct];
        const float lbr = lb[ct] - mref[ct];
#pragma unroll
        for (int st = 0; st < 4; ++st) { const float c0 = fmaf(skv, (float)(16 * st), lbr); sc[ct][st] = (f32x4){c0, c0 + skv, fmaf(skv, 2.f, c0), fmaf(skv, 3.f, c0)}; }
    }
#pragma unroll
    for (int st = 0; st < 4; ++st) {
#pragma unroll
        for (int ks = 0; ks < 2; ++ks) {
            const bf16x8 kf = *(const LAS bf16x8*)(Kb + (16 * st + col) * 64 + (((4 * ks + slab) ^ sw) << 3));
#pragma unroll
            for (int ct = 0; ct < 2; ++ct) sc[ct][st] = __builtin_amdgcn_mfma_f32_16x16x32_bf16(kf, qf[ct][ks], sc[ct][st], 0, 0, 0);
        }
        asm volatile("" ::: "memory");
    }
    if (MASK) {
        const int lo2 = lo - 4 * slab, hi2 = hi - 4 * slab;
#pragma unroll
        for (int ct = 0; ct < 2; ++ct)
#pragma unroll
            for (int st = 0; st < 4; ++st)
#pragma unroll
                for (int r = 0; r < 4; ++r) { const int kk = 16 * st + r; sc[ct][st][r] = (kk >= lo2 && kk <= hi2) ? sc[ct][st][r] : -1e30f; }
    }
    if (KIND != 2) {
        float mxl[2];
#pragma unroll
        for (int ct = 0; ct < 2; ++ct) {
            float mx = -1e30f;
#pragma unroll
            for (int st = 0; st < 4; ++st) mx = fmaxf(fmaxf(mx, fmaxf(sc[ct][st][0], sc[ct][st][1])), fmaxf(sc[ct][st][2], sc[ct][st][3]));
            mxl[ct] = mx;
        }
        const bool slow = __any((mxl[0] > LAZY_THR) || (mxl[1] > LAZY_THR) || (m[0] < -1e19f) || (m[1] < -1e19f));
        if (slow) {
#pragma unroll
            for (int ct = 0; ct < 2; ++ct) {
                const float mx = xmax_16_32(mxl[ct]);
                const float mrel = m[ct] - mref[ct];
                const float mn = fmaxf(mrel, mx);
                const float alpha = __builtin_amdgcn_exp2f(mrel - mn);
                m[ct] = mref[ct] + mn; l[ct] *= alpha;
#pragma unroll
                for (int st = 0; st < 4; ++st) sc[ct][st] = sc[ct][st] - mn;
                if (KIND == 0) {
#pragma unroll
                    for (int dt = 0; dt < 4; ++dt) O[ct][dt] = O[ct][dt] * alpha;
                }
            }
        }
    }
#pragma unroll
    for (int ct = 0; ct < 2; ++ct) {
        f32x4 sum4 = (f32x4){0.f, 0.f, 0.f, 0.f};
#pragma unroll
        for (int st = 0; st < 4; ++st) {
            f32x4 e;
#pragma unroll
            for (int r = 0; r < 4; ++r) e[r] = __builtin_amdgcn_exp2f(sc[ct][st][r]);
            if (KIND == 2) e = e * l[ct];
            sc[ct][st] = e; sum4 += e;
        }
        if (KIND != 2) l[ct] += (sum4[0] + sum4[1]) + (sum4[2] + sum4[3]);
    }
    if (KIND == 1) return;
    if (KIND == 2) {
#pragma unroll
        for (int st = 0; st < 4; ++st) {
            float g4 = (sc[0][st][0] + sc[0][st][1]) + (sc[0][st][2] + sc[0][st][3]) + (sc[1][st][0] + sc[1][st][1]) + (sc[1][st][2] + sc[1][st][3]);
            g4 += __shfl_xor(g4, 8);
            if ((col & 8) == 0) imp_row[jbase + 4 * st + slab] += g4;
        }
        asm volatile("s_waitcnt lgkmcnt(0)" ::: "memory");
#pragma unroll
        for (int st = 0; st < 4; ++st) {
            float la = sc[0][st][3] + sc[1][st][3];
            la += __shfl_xor(la, 8);
            if ((col & 8) == 0) imp_row[jbase + 4 * st + slab + 1] += la;
        }
    }
#pragma unroll
    for (int ks2 = 0; ks2 < 2; ++ks2) {
        bf16x8 pf[2];
#pragma unroll
        for (int ct = 0; ct < 2; ++ct) { const u32x4 w = pack8(sc[ct][2 * ks2], sc[ct][2 * ks2 + 1]); pf[ct] = *(const bf16x8*)&w; }
#pragma unroll
        for (int dt = 0; dt < 4; ++dt) {
            const LAS bf16_t* vrow = Vb + (16 * dt + col) * 64 + 4 * (slab & 1);
            const int vc = (4 * ks2 + (slab >> 1)) ^ sw;
            const u32x2 a0 = *(const LAS u32x2*)(vrow + (vc << 3)), a1 = *(const LAS u32x2*)(vrow + ((vc ^ 2) << 3));
            const u32x4 aw = (u32x4){a0.x, a0.y, a1.x, a1.y};
            const bf16x8 vf = *(const bf16x8*)&aw;
#pragma unroll
            for (int ct = 0; ct < 2; ++ct) O[ct][dt] = __builtin_amdgcn_mfma_f32_16x16x32_bf16(vf, pf[ct], O[ct][dt], 0, 0, 0);
            asm volatile("" ::: "memory");
        }
    }
}

__device__ __forceinline__ int sum_jg(int x) {
    x += __builtin_amdgcn_update_dpp(0, x, 0x128, 0xf, 0xf, false);
    auto a = __builtin_amdgcn_permlane16_swap((unsigned)x, (unsigned)x, false, false);
    x = (int)(a[0] + a[1]);
    auto b = __builtin_amdgcn_permlane32_swap((unsigned)x, (unsigned)x, false, false);
    return (int)(b[0] + b[1]);
}
__device__ __forceinline__ unsigned pick4(const unsigned (&a)[4], int i) { return i == 0 ? a[0] : (i == 1 ? a[1] : (i == 2 ? a[2] : a[3])); }
__device__ __forceinline__ void attn_phase(const Params& p, LAS unsigned char* lds) {
    unsigned char* ws = p.ws;
    const bf16_t* qbuf = (const bf16_t*)(ws + WS_Q); const float* gates = (const float*)(ws + WS_GATES);
    const bf16_t* kcmp = (const bf16_t*)(ws + WS_KCMP); const bf16_t* vcmp = (const bf16_t*)(ws + WS_VCMP);
    const bf16_t* kslc = (const bf16_t*)(ws + WS_KSLC); const bf16_t* vslc = (const bf16_t*)(ws + WS_VSLC);
    const bf16_t* kwin = (const bf16_t*)(ws + WS_KWIN); const bf16_t* vwin = (const bf16_t*)(ws + WS_VWIN);
    bf16_t* obuf = (bf16_t*)(ws + WS_O);
    const int tid = threadIdx.x, lane = tid & 63, w = __builtin_amdgcn_readfirstlane(tid >> 6), col = lane & 15, slab = lane >> 4, qi = lane & 7;
    LAS bf16_t* Ksm = (LAS bf16_t*)(lds + A_K); LAS bf16_t* Vsm = (LAS bf16_t*)(lds + A_V);
    LAS float* imp = (LAS float*)(lds + A_IMP); LAS unsigned* wun = (LAS unsigned*)(lds + A_WUN); LAS unsigned short* tl = (LAS unsigned short*)(lds + A_TL);
    LAS float* imp_row = imp + (8 * w + qi) * IMP_P;
    LAS unsigned* selw = (LAS unsigned*)(lds + A_SEL) + (8 * w + qi) * 4;
    const int dsrc = (tid >> 3) * 64 + ((((tid & 7) ^ ((tid >> 4) & 7))) << 3);
#define ATT_DMA(kptr, vptr, buf) do { \
        __builtin_amdgcn_global_load_lds((const unsigned*)((kptr) + dsrc), (LAS unsigned*)(lds + A_K + (buf) * 8192 + w * 1024), 16, 0, 0); \
        __builtin_amdgcn_global_load_lds((const unsigned*)((vptr) + dsrc), (LAS unsigned*)(lds + A_V + (buf) * 8192 + w * 1024), 16, 0, 0); } while (0)
#define ATT_WAIT(more) do { if (more) asm volatile("s_waitcnt vmcnt(2)" ::: "memory"); else asm volatile("s_waitcnt vmcnt(0)" ::: "memory"); \
        __builtin_amdgcn_s_barrier(); asm volatile("" ::: "memory"); } while (0)

    unsigned* qctr = (unsigned*)(ws + WS_KMAX) + 16;
    LAS int* qslot = (LAS int*)(lds + A_TL + 448);
    if (tid == 0) qslot[0] = (int)__hip_atomic_fetch_add(qctr, 1u, __ATOMIC_RELAXED, __HIP_MEMORY_SCOPE_AGENT);
    __syncthreads();
    int ui = __builtin_amdgcn_readfirstlane(qslot[0]);
    while (ui < 2048) {
        int nxt_ui = 0;
        const int qb = 127 - (ui >> 4), bgi = ui & 15, b = bgi >> 2, g = bgi & 3;
        const int ql = 8 * w + qi, t = qb * 64 + ql;
        const int tok = b * SEQ + t;
        bf16x8 qf[2][2]; float slope2[2]; int hh[2];
#pragma unroll
        for (int ct = 0; ct < 2; ++ct) {
            hh[ct] = 4 * g + 2 * ct + (col >> 3);
            slope2[ct] = exp2f(-0.5f * (float)(hh[ct] + 1)) * LOG2E;
#pragma unroll
            for (int ks = 0; ks < 2; ++ks) qf[ct][ks] = *(const bf16x8*)(qbuf + (size_t)tok * 1024 + hh[ct] * 64 + 32 * ks + 8 * slab);
        }
        for (int i = lane; i < 8 * IMP_P; i += 64) imp[8 * w * IMP_P + i] = 0.f;
        f32x4 O[2][4]; float m[2], l[2];
        LAS f32x4* ofin = (LAS f32x4*)(lds + A_OFIN) + tid;
#pragma unroll
        for (int ct = 0; ct < 2; ++ct) { m[ct] = -1e20f; l[ct] = 0.f;
#pragma unroll
            for (int dt = 0; dt < 4; ++dt) O[ct][dt] = (f32x4){0.f, 0.f, 0.f, 0.f}; }
        float lb[2]; float skmul;
        const int nkt = (4 * qb + 3 + 63) >> 6;
        const int nmax = (t - 31) >> 4;
        int nproc;
        {
            const float kinf = __uint_as_float(((const unsigned*)(ws + WS_KMAX))[bgi]) * 1.01f;
            int kneed = nkt - 1;
#pragma unroll
            for (int ct = 0; ct < 2; ++ct) {
                float qn = 0.f;
#pragma unroll
                for (int ks = 0; ks < 2; ++ks)
#pragma unroll
                    for (int e = 0; e < 8; ++e) qn += __uint_as_float(((unsigned)(unsigned short)qf[ct][ks][e] & 0x7fffu) << 16);
                qn = xsum_16_32(qn) * 1.001f;
                const float X = ((float)t - 1055.f - (170.f + 2.f * qn * kinf) / slope2[ct]) * (1.0f / 1024.0f);
                const int kn = X > 0.f ? (int)ceilf(X) : 0;
                kneed = kn < kneed ? kn : kneed;
            }
#pragma unroll
            for (int o = 1; o < 16; o <<= 1) { const int other = __shfl_xor(kneed, o); kneed = other < kneed ? other : kneed; }
            LAS int* knw = (LAS int*)(lds + A_TL + 384);
            if (lane == 0) knw[w] = kneed;
            __syncthreads();
            int ktmin = knw[0];
#pragma unroll
            for (int w2 = 1; w2 < 8; ++w2) { const int v = knw[w2]; ktmin = v < ktmin ? v : ktmin; }
            nproc = nkt - __builtin_amdgcn_readfirstlane(ktmin);
        }
        const int n1 = 2 * nproc;
        const bf16_t* kc0 = kcmp + (size_t)bgi * 512 * 64; const bf16_t* vc0 = vcmp + (size_t)bgi * 8 * 4096;
#define KT1(i) (nkt - 1 - (((i) < nproc) ? (i) : (i) - nproc))
        asm volatile("" :: "v"(qf[0][0]), "v"(qf[0][1]), "v"(qf[1][0]), "v"(qf[1][1]));
        if (tid == 0) nxt_ui = (int)atomicInc(qctr, 0xffffffffu);
        ATT_DMA(kc0 + KT1(0) * 4096, vc0 + KT1(0) * 4096, 0);
        ATT_DMA(kc0 + KT1(1) * 4096, vc0 + KT1(1) * 4096, 1);
        skmul = 16.f;
        const int nmax_min = (qb * 64 + 8 * w - 31) >> 4;
        int cb = 0;
        for (int i = 0; i < n1; ++i) {
            ATT_WAIT(i + 1 < n1);
            if (i + 2 < n1) { const int nb = cb == 0 ? 2 : cb - 1; ATT_DMA(kc0 + KT1(i + 2) * 4096, vc0 + KT1(i + 2) * 4096, nb); }
            const LAS bf16_t* Kb = Ksm + cb * 4096; const LAS bf16_t* Vb = Vsm + cb * 4096;
            cb = cb == 2 ? 0 : cb + 1;
            const int kt = KT1(i);
#pragma unroll
            for (int ct = 0; ct < 2; ++ct) lb[ct] = slope2[ct] * (16.f * (float)(64 * kt + 4 * slab) + 15.5f - (float)t);
            const int hi = nmax - 64 * kt;
            const bool cmask = (64 * kt + 63 > nmax_min);
            if (i < nproc) { if (cmask) attn_tile<true, 1>(Kb, Vb, qf, O, m, l, lb, slope2, skmul, 0, hi, col, slab, imp_row, 0);
                           else attn_tile<false, 1>(Kb, Vb, qf, O, m, l, lb, slope2, skmul, 0, 63, col, slab, imp_row, 0); }
            else {
                if (i == nproc) {
#pragma unroll
                    for (int ct = 0; ct < 2; ++ct) { float lt = xsum_16_32(l[ct]); l[ct] = lt > 0.f ? fast_rcp(lt) : 0.f; }
                }
                if (cmask) attn_tile<true, 2>(Kb, Vb, qf, O, m, l, lb, slope2, skmul, 0, hi, col, slab, imp_row, 16 * kt);
                else attn_tile<false, 2>(Kb, Vb, qf, O, m, l, lb, slope2, skmul, 0, 63, col, slab, imp_row, 16 * kt);
            }
        }
        {
#pragma unroll
            for (int ct = 0; ct < 2; ++ct) { const float g0 = gates[(size_t)tok * 48 + hh[ct] * 3 + 0];
#pragma unroll
                for (int dt = 0; dt < 4; ++dt) { ofin[(ct * 4 + dt) * 512] = O[ct][dt] * g0; O[ct][dt] = (f32x4){0.f, 0.f, 0.f, 0.f}; }
                m[ct] = -1e20f; l[ct] = 0.f; }
        }
        unsigned sel[4];
        {
            const int jg = lane >> 3;
            unsigned m16 = 0;
            if (qb - 2 <= 13) {
#pragma unroll
                for (int e = 0; e < 16; ++e) if (16 * jg + e <= qb) m16 |= 1u << e;
            } else {
                unsigned key[16];
#pragma unroll
                for (int e = 0; e < 16; ++e) { const int j = 16 * jg + e; const float v = imp_row[j]; key[e] = (j >= 1 && j <= qb - 2) ? (__float_as_uint(v) + 1u) : 0u; }
                unsigned Tt = 0;
                for (int bit = 30; bit >= 0; --bit) {
                    const unsigned cand = Tt | (1u << bit); int cnt = 0;
#pragma unroll
                    for (int e = 0; e < 16; ++e) cnt += (key[e] >= cand) ? 1 : 0;
                    cnt = sum_jg(cnt);
                    if (cnt >= 13) Tt = cand;
                }
                int cgt = 0, ceq = 0;
#pragma unroll
                for (int e = 0; e < 16; ++e) { cgt += (key[e] > Tt) ? 1 : 0; ceq += (key[e] == Tt) ? 1 : 0; }
                cgt = sum_jg(cgt);
                const int need = 13 - cgt;
                int run = 0;
#pragma unroll
                for (int j2 = 0; j2 < 8; ++j2) { const int c = __shfl(ceq, qi + 8 * j2); if (j2 < jg) run += c; }
#pragma unroll
                for (int e = 0; e < 16; ++e) {
                    if (key[e] > Tt) m16 |= 1u << e;
                    else if (key[e] == Tt) { if (run < need) m16 |= 1u << e; ++run; }
                }
#pragma unroll
                for (int e = 0; e < 16; ++e) { const int j = 16 * jg + e; if (j == 0 || j == qb || j == qb - 1) m16 |= 1u << e; }
            }
            sel[0] = sel[1] = sel[2] = sel[3] = 0u;
#pragma unroll
            for (int j2 = 0; j2 < 8; ++j2) { const unsigned v = (unsigned)__shfl((int)m16, qi + 8 * j2); sel[j2 >> 1] |= v << (16 * (j2 & 1)); }
        }
        if (lane < 8) {
#pragma unroll
            for (int k4 = 0; k4 < 4; ++k4) selw[k4] = sel[k4];
        }
        unsigned wu[4];
#pragma unroll
        for (int k4 = 0; k4 < 4; ++k4) { unsigned x = sel[k4]; x |= (unsigned)__shfl_xor((int)x, 1); x |= (unsigned)__shfl_xor((int)x, 2); x |= (unsigned)__shfl_xor((int)x, 4); wu[k4] = (unsigned)__builtin_amdgcn_readfirstlane((int)x); if (lane == 0) wun[w * 4 + k4] = x; }
        __syncthreads();
        unsigned un[4] = {0u, 0u, 0u, 0u};
#pragma unroll
        for (int w2 = 0; w2 < 8; ++w2)
#pragma unroll
            for (int k4 = 0; k4 < 4; ++k4) un[k4] |= wun[w2 * 4 + k4];
#pragma unroll
        for (int k4 = 0; k4 < 4; ++k4) un[k4] = (unsigned)__builtin_amdgcn_readfirstlane((int)un[k4]);
        const int nslc = __popc(un[0]) + __popc(un[1]) + __popc(un[2]) + __popc(un[3]);
        const int jw0 = qb >= 8 ? qb - 8 : 0, nwin = qb - jw0 + 1, n2 = nslc + nwin;
        int tidl = tid; asm volatile("" : "+v"(tidl));
        if (tidl < 128) {
            const int j = tidl, wd = j >> 5, bi = j & 31;
            const unsigned uw = pick4(un, wd);
            if ((uw >> bi) & 1u) {
                int pos = __popc(uw & ((1u << bi) - 1u));
#pragma unroll
                for (int k4 = 0; k4 < 4; ++k4) if (k4 < wd) pos += __popc(un[k4]);
                tl[nslc - 1 - pos] = (unsigned short)j;
            }
        } else if (tidl < 128 + nwin) tl[nslc + (tidl - 128)] = (unsigned short)(0x100 | (qb - (tidl - 128)));
        __syncthreads();
        {
            skmul = 1.f;
#define ATT_DMA2(idx, buf) do { const int _e = tl[idx]; const int _j = _e & 0xff; const bool _w = _e >> 8; \
                ATT_DMA((_w ? kwin : kslc) + ((size_t)bgi * SEQ + 64 * _j) * 64, (_w ? vwin : vslc) + ((size_t)bgi * 128 + _j) * 4096, buf); } while (0)
            ATT_DMA2(0, 0);
            ATT_DMA2(1, 1);
            int cb = 0;
            for (int i = 0; i < n2; ++i) {
                ATT_WAIT(i + 1 < n2);
                if (i + 2 < n2) { const int nb = cb == 0 ? 2 : cb - 1; ATT_DMA2(i + 2, nb); }
                const int buf3 = cb; cb = cb == 2 ? 0 : cb + 1;
                const int e = tl[i];
                const int j = e & 0xff; const bool isw = e >> 8;
#pragma unroll
                for (int ct = 0; ct < 2; ++ct) lb[ct] = slope2[ct] * ((float)(64 * j + 4 * slab) - (float)t);
                const LAS bf16_t* Kb = Ksm + buf3 * 4096; const LAS bf16_t* Vb = Vsm + buf3 * 4096;
                if (isw && i == nslc) {
#pragma unroll
                    for (int ct = 0; ct < 2; ++ct) { float lt = xsum_16_32(l[ct]);
                        const float sc1 = (lt > 0.f ? fast_rcp(lt) : 0.f) * gates[(size_t)tok * 48 + hh[ct] * 3 + 1];
#pragma unroll
                        for (int dt = 0; dt < 4; ++dt) { ofin[(ct * 4 + dt) * 512] += O[ct][dt] * sc1; O[ct][dt] = (f32x4){0.f, 0.f, 0.f, 0.f}; }
                        m[ct] = -1e20f; l[ct] = 0.f; }
                }
                int tlo = 0, thi = 63; bool active = true, domask = false;
                if (!isw) {
                    active = (pick4(wu, j >> 5) >> (j & 31)) & 1u;
                    const bool cval = (selw[j >> 5] >> (j & 31)) & 1u;
                    thi = cval ? (j == qb ? ql : 63) : -1;
                    domask = (j == qb) || !__all(cval);
                } else {
                    if (j == qb) { thi = ql; domask = true; }
                    else if (j == qb - 8) { tlo = ql + 1; domask = true; }
                }
                if (active) {
                    if (domask) attn_tile<true, 0>(Kb, Vb, qf, O, m, l, lb, slope2, skmul, tlo, thi, col, slab, imp_row, 0);
                    else attn_tile<false, 0>(Kb, Vb, qf, O, m, l, lb, slope2, skmul, 0, 63, col, slab, imp_row, 0);
                }
            }
        }
#pragma unroll
        for (int ct = 0; ct < 2; ++ct) { float lt = xsum_16_32(l[ct]);
            const float sc2 = (lt > 0.f ? fast_rcp(lt) : 0.f) * gates[(size_t)tok * 48 + hh[ct] * 3 + 2];
#pragma unroll
            for (int dt = 0; dt < 4; ++dt) {
                const f32x4 o = ofin[(ct * 4 + dt) * 512] + O[ct][dt] * sc2;
                u32x2 wv2; wv2.x = cvt_pk_bf16(o[0], o[1]); wv2.y = cvt_pk_bf16(o[2], o[3]);
                *(u32x2*)(obuf + (size_t)tok * 1024 + hh[ct] * 64 + 16 * dt + 4 * slab) = wv2;
            } }
        if (tid == 0) qslot[0] = nxt_ui;
        __syncthreads();
        ui = __builtin_amdgcn_readfirstlane(qslot[0]);
    }
}

__device__ __forceinline__ void final_phase(const Params& p) {
    float* out = p.out; const bf16_t* hb = (const bf16_t*)(p.ws + WS_HB); const float* part = (const float*)(p.ws + WS_PART) + (size_t)4 * T * 16; const float* gn = p.in[19];
    const int lane = threadIdx.x & 63, wv = threadIdx.x >> 6;
    for (int r = blockIdx.x * 8 + wv; r < T; r += gridDim.x * 8) {
        const float rs = row_rstd(part, r);
#pragma unroll
        for (int j = 0; j < 2; ++j) {
            const u32x4 w = *(const u32x4*)(hb + (size_t)r * 1024 + j * 512 + lane * 8);
            const f32x4 g0 = *(const f32x4*)(gn + j * 512 + lane * 8), g1 = *(const f32x4*)(gn + j * 512 + lane * 8 + 4);
            f32x4* o = (f32x4*)(out + (size_t)r * 1024 + j * 512 + lane * 8);
            __builtin_nontemporal_store((f32x4){bf_lo(w.x), bf_hi(w.x), bf_lo(w.y), bf_hi(w.y)} * rs * g0, o);
            __builtin_nontemporal_store((f32x4){bf_lo(w.z), bf_hi(w.z), bf_lo(w.w), bf_hi(w.w)} * rs * g1, o + 1);
        }
    }
}

#define XB_TMO      128
#define XB_XCNT(j)  (256  + 64 * (j))
#define XB_XSUB(j)  (1280 + 64 * (j))
#define XB_XGEN(j)  (2304 + 64 * (j))
#define XB_TOP      3328
#define XB_TOPGEN   3392
#define XCD_BAR_WORDS 3456
#define XB_SPIN_CAP (1u << 18)
__device__ __forceinline__ unsigned xb_ld(unsigned* p)              { return __hip_atomic_load(p, __ATOMIC_RELAXED, __HIP_MEMORY_SCOPE_AGENT); }
__device__ __forceinline__ unsigned xb_add(unsigned* p, unsigned v) { return __hip_atomic_fetch_add(p, v, __ATOMIC_RELAXED, __HIP_MEMORY_SCOPE_AGENT); }
__device__ __forceinline__ unsigned xb_xcc_id() { return (unsigned)__builtin_amdgcn_s_getreg((3 << 11) | 20) & 0xFu; }
#define XB_SPIN(cond, bar) do { unsigned _sp = 0; while (cond) { __builtin_amdgcn_s_sleep(1); \
    if ((++_sp & 255u) == 0u) { if (xb_ld(&(bar)[XB_TMO])) break; if (_sp > XB_SPIN_CAP) { atomicAdd(&(bar)[XB_TMO], 1u); break; } } } } while (0)
struct XcdBarrier { unsigned* bar; unsigned x; volatile LAS unsigned* st; };
__device__ __forceinline__ XcdBarrier xcd_barrier_post(unsigned* bar, volatile LAS unsigned* st) {
    XcdBarrier b; b.bar = bar; b.x = xb_xcc_id(); b.st = st;
    if (threadIdx.x == 0) (void)xb_add(&bar[XB_XCNT(b.x)], 1u);
    return b;
}
__device__ __forceinline__ void xcd_barrier_complete(unsigned* bar, unsigned x, unsigned& nloc, unsigned& nx) {
    const unsigned G = gridDim.x * gridDim.y * gridDim.z;
    unsigned sum, cnt, mine, sp = 0u;
    for (;;) {
        sum = 0u; cnt = 0u; mine = 0u;
#pragma unroll
        for (unsigned j = 0; j < 16; ++j) { const unsigned c = xb_ld(&bar[XB_XCNT(j)]); sum += c; cnt += (c > 0u) ? 1u : 0u; mine = (j == x) ? c : mine; }
        if (sum == G) break;
        __builtin_amdgcn_s_sleep(1);
        if ((++sp & 255u) == 0u) { if (xb_ld(&bar[XB_TMO])) break; if (sp > XB_SPIN_CAP) { atomicAdd(&bar[XB_TMO], 1u); break; } }
    }
    nloc = mine > 0u ? mine : 1u; nx = cnt > 0u ? cnt : 1u;
}
__device__ __forceinline__ void xcd_barrier(const XcdBarrier& b) {
    asm volatile("s_waitcnt vmcnt(0)" ::: "memory");
    __syncthreads();
    if (threadIdx.x == 0) {
        unsigned* bar = b.bar;
        __builtin_amdgcn_s_waitcnt(0);
        unsigned nloc = b.st[0], nx = b.st[1];
        if (nloc == 0u) { xcd_barrier_complete(bar, b.x, nloc, nx); b.st[0] = nloc; b.st[1] = nx; }
        const unsigned old = xb_add(&bar[XB_XSUB(b.x)], 1u);
        const unsigned gen = old / nloc;
        if (old + 1u == (gen + 1u) * nloc) {
            __builtin_amdgcn_fence(__ATOMIC_RELEASE, "agent");
            asm volatile("s_waitcnt vmcnt(0)" ::: "memory");
            const unsigned og = xb_add(&bar[XB_TOP], 1u);
            const unsigned tg = og / nx;
            if (og + 1u == (tg + 1u) * nx) xb_add(&bar[XB_TOPGEN], 1u);
            else XB_SPIN(xb_ld(&bar[XB_TOPGEN]) == tg, bar);
            __builtin_amdgcn_fence(__ATOMIC_ACQUIRE, "agent");
            xb_add(&bar[XB_XGEN(b.x)], 1u);
            asm volatile("s_waitcnt vmcnt(0)" ::: "memory");
        } else {
            XB_SPIN(xb_ld(&bar[XB_XGEN(b.x)]) == gen, bar);
            __builtin_amdgcn_fence(__ATOMIC_ACQUIRE, "agent");
            asm volatile("s_waitcnt vmcnt(0)" ::: "memory");
        }
    }
    __syncthreads();
}

__global__ void __launch_bounds__(512, 2) fwd_megakernel(Params p) {
    extern __shared__ __attribute__((aligned(16))) unsigned char smem[];
    LAS unsigned char* lds = (LAS unsigned char*)smem;
    cg::grid_group grid = cg::this_grid();
    unsigned char* ws = p.ws;
    float* part = (float*)(ws + WS_PART);
    const int G = gridDim.x, bx = blockIdx.x;
    const int lo = p.ph_lo, hi = p.ph_hi;
#ifndef PH_MASK
#define PH_MASK 0xffff
#endif
#define IN(k) (((PH_MASK >> (k)) & 1) && lo <= (k) && (k) < hi)
    volatile LAS unsigned* xst = (volatile LAS unsigned*)(lds + LDS_BYTES - 16);
    if (threadIdx.x == 0) { xst[0] = 0u; xst[1] = 0u; }
    __syncthreads();
    XcdBarrier xbar; xbar.bar = (unsigned*)(ws + WS_BAR); xbar.x = 0u; xbar.st = xst;
#define SEAM(k) do { if (IN(k) && IN((k) + 1)) { if ((k) == 0) { grid.sync(); xbar = xcd_barrier_post((unsigned*)(ws + WS_BAR), xst); } else xcd_barrier(xbar); } } while (0)
    if (IN(0)) prep_phase(p, lds);
    SEAM(0);
    if (IN(1)) { pg8::Gemm g{(const bf16_t*)(ws + WS_HB), (const bf16_t*)(ws + WS_WIN), 1024, 1024}; pg8::StaticOrder S; S.init(T, 3072, G, bx);
        EpiWin E{part, (bf16_t*)(ws + WS_CV), (bf16_t*)(ws + WS_BG)}; pg8::gemm_phase(lds, g, S, E); }
    SEAM(1);
    if (IN(2)) conv_phase(p);
    SEAM(2);
    if (IN(3)) { pg8::Gemm g{(const bf16_t*)(ws + WS_U), (const bf16_t*)(ws + WS_WOUT), 1024, 1024}; pg8::StaticOrder S; S.init(T, 1024, G, bx);
        EpiResB E{(bf16_t*)(ws + WS_HB), part + (size_t)1 * T * 16}; pg8::gemm_phase(lds, g, S, E); }
    SEAM(3);
    if (IN(4)) { pg8::Gemm g{(const bf16_t*)(ws + WS_HB), (const bf16_t*)(ws + WS_WGU0), 1024, 1024}; pg8::StaticOrder S; S.init(T, 5632, G, bx);
        EpiGu E{part + (size_t)1 * T * 16, (bf16_t*)(ws + WS_HID)}; pg8::gemm_phase(lds, g, S, E); }
    SEAM(4);
    if (IN(5)) { pg8::Gemm g{(const bf16_t*)(ws + WS_HID), (const bf16_t*)(ws + WS_WDN0), FF, FF}; pg8::StaticOrder S; S.init(T, 1024, G, bx);
        EpiResB E{(bf16_t*)(ws + WS_HB), part + (size_t)2 * T * 16}; pg8::gemm_phase(lds, g, S, E); }
    SEAM(5);
    if (IN(6)) { pg8::Gemm g{(const bf16_t*)(ws + WS_HB), (const bf16_t*)(ws + WS_WKVQG), 1024, 1024}; pg8::StaticOrder S; S.init(T, 2560, G, bx);
        EpiKvqg E{part + (size_t)2 * T * 16, ws}; pg8::gemm_phase(lds, g, S, E); }
    SEAM(6);
    if (IN(7)) {
        const bool split = G >= 256;
        if (!split || bx < 128) { pg8::Gemm g{(const bf16_t*)(ws + WS_CMPRAW), (const bf16_t*)(ws + WS_WC1), 1024, 1024}; pg8::CmpOrder S{split ? 128 : G, bx};
            EpiCmp E{(bf16_t*)(ws + WS_O)}; pg8::gemm_phase(lds, g, S, E); }
        if (!split || bx >= 128) { pg8::Gemm g{(const bf16_t*)(ws + WS_HB), (const bf16_t*)(ws + WS_WKVQG), 1024, 1024}; pg8::GateOrder S{split ? G - 128 : G, split ? bx - 128 : bx};
            EpiKvqg E{part + (size_t)2 * T * 16, ws}; pg8::gemm_phase(lds, g, S, E); }
    }
    SEAM(7);
    if (IN(8)) cmp2_phase(p);
    SEAM(8);
    if (IN(9)) attn_phase(p, lds);
    SEAM(9);
    if (IN(10)) { pg8::Gemm g{(const bf16_t*)(ws + WS_O), (const bf16_t*)(ws + WS_WO), 1024, 1024}; pg8::StaticOrder S; S.init(T, 1024, G, bx);
        EpiResB E{(bf16_t*)(ws + WS_HB), part + (size_t)3 * T * 16}; pg8::gemm_phase(lds, g, S, E); }
    SEAM(10);
    if (IN(11)) { pg8::Gemm g{(const bf16_t*)(ws + WS_HB), (const bf16_t*)(ws + WS_WGU1), 1024, 1024}; pg8::StaticOrder S; S.init(T, 5632, G, bx);
        EpiGu E{part + (size_t)3 * T * 16, (bf16_t*)(ws + WS_HID)}; pg8::gemm_phase(lds, g, S, E); }
    SEAM(11);
    if (IN(12)) { pg8::Gemm g{(const bf16_t*)(ws + WS_HID), (const bf16_t*)(ws + WS_WDN1), FF, FF}; pg8::StaticOrder S; S.init(T, 1024, G, bx);
        EpiResB E{(bf16_t*)(ws + WS_HB), part + (size_t)4 * T * 16}; pg8::gemm_phase(lds, g, S, E); }
    SEAM(12);
    if (IN(13)) final_phase(p);
#ifdef DUMP_BASE
    SEAM(13);
    if (lo <= 14 && 14 < hi) {
        const unsigned short* src = (const unsigned short*)(ws + (size_t)(DUMP_BASE));
        const size_t n = (size_t)T * 1024;
        for (size_t i = (size_t)bx * 512 + threadIdx.x; i < n; i += (size_t)G * 512) p.out[i] = (float)src[i] + (float)src[i + n] + (float)src[i + 2 * n];
    }
#endif
}

#ifdef DUMP_BASE
constexpr int N_PHASES = 15;
#else
constexpr int N_PHASES = 14;
#endif
#ifndef N_LAUNCH_SPLIT
#define N_LAUNCH_SPLIT 0
#endif
extern "C" void kernel_launch(void* const* d_in, const int* in_sizes, int n_in, void* d_out, int out_size, void* d_ws, size_t ws_size, hipStream_t stream) {
    static int grid_blocks = 0;
    if (!grid_blocks) {
        int dev = 0, cus = 0, per_cu = 0;
        hipGetDevice(&dev);
        hipDeviceGetAttribute(&cus, hipDeviceAttributeMultiprocessorCount, dev);
        hipFuncSetAttribute((const void*)fwd_megakernel, hipFuncAttributeMaxDynamicSharedMemorySize, LDS_BYTES);
        hipOccupancyMaxActiveBlocksPerMultiprocessor(&per_cu, (const void*)fwd_megakernel, 512, LDS_BYTES);
        if (per_cu < 1) { fprintf(stderr, "occupancy query returned %d\n", per_cu); per_cu = 1; }
        grid_blocks = cus * 1;
    }
    Params p{};
    for (int i = 0; i < 20; ++i) p.in[i] = (const float*)d_in[i];
    p.out = (float*)d_out; p.ws = (unsigned char*)d_ws;
#if N_LAUNCH_SPLIT
    for (int ph = 0; ph < N_PHASES; ++ph) {
        p.ph_lo = ph; p.ph_hi = ph + 1;
        void* args[] = {&p};
        hipError_t e = hipLaunchCooperativeKernel((const void*)fwd_megakernel, dim3(grid_blocks), dim3(512), args, LDS_BYTES, stream);
        if (e != hipSuccess) fprintf(stderr, "cooperative launch failed: %s (grid %d)\n", hipGetErrorString(e), grid_blocks);
    }
#else
    p.ph_lo = 0; p.ph_hi = N_PHASES;
    void* args[] = {&p};
    hipError_t e = hipLaunchCooperativeKernel((const void*)fwd_megakernel, dim3(grid_blocks), dim3(512), args, LDS_BYTES, stream);
    if (e != hipSuccess) fprintf(stderr, "cooperative launch failed: %s (grid %d)\n", hipGetErrorString(e), grid_blocks);
#endif
}
```

```cpp
#include <hip/hip_runtime.h>
#include <hip/hip_cooperative_groups.h>
#include <cstdio>
namespace cg = cooperative_groups;

#define LAS __attribute__((address_space(3)))
typedef unsigned short bf16_t;
typedef short bf16x8 __attribute__((ext_vector_type(8)));
typedef float f32x4 __attribute__((ext_vector_type(4)));
typedef short bf16x4 __attribute__((ext_vector_type(4)));
typedef unsigned u32x4 __attribute__((ext_vector_type(4)));
typedef unsigned u32x2 __attribute__((ext_vector_type(2)));

constexpr int T = 32768, DM = 1024, SEQ = 8192, FF = 2816;
constexpr float LOG2E = 1.4426950408889634f;
constexpr size_t MBY = 1u << 20;
constexpr size_t WS_PART = 0;
constexpr size_t WS_BAR = 10 * MBY + 512 * 1024;
constexpr size_t WS_KMAX = 10 * MBY + 768 * 1024;
constexpr size_t WS_CBIAS = 11 * MBY;
constexpr size_t WS_WIN = 12 * MBY;
constexpr size_t WS_WOUT = 18 * MBY;
constexpr size_t WS_WGU0 = 20 * MBY;
constexpr size_t WS_WGU1 = 31 * MBY;
constexpr size_t WS_WDN0 = 42 * MBY;
constexpr size_t WS_WDN1 = 48 * MBY;
constexpr size_t WS_WKVQG = 54 * MBY;
constexpr size_t WS_WC1 = 60 * MBY;
constexpr size_t WS_WO = 62 * MBY;
constexpr size_t WS_WC2 = 64 * MBY;
constexpr size_t WS_HB = 65 * MBY;
constexpr size_t WS_HRES = 129 * MBY;
constexpr size_t WS_R = 257 * MBY;
constexpr size_t WS_CV = WS_R, WS_BG = WS_R + 64 * MBY, WS_U = WS_R + 128 * MBY;
constexpr size_t WS_HID = WS_R;
constexpr size_t WS_CMPRAW = WS_R;
constexpr size_t WS_KSLC = WS_R + 33 * MBY, WS_VSLC = WS_R + 49 * MBY, WS_KWIN = WS_R + 65 * MBY, WS_VWIN = WS_R + 81 * MBY;
constexpr size_t WS_Q = WS_R + 97 * MBY;
constexpr size_t WS_GATES = WS_R + 161 * MBY;
constexpr size_t WS_CHID = WS_R + 168 * MBY;
constexpr size_t WS_KCMP = WS_R + 176 * MBY;
constexpr size_t WS_VCMP = WS_R + 177 * MBY;
constexpr size_t WS_O = WS_R + 178 * MBY;
constexpr int LDS_BYTES = 155648;

struct Params { const float* in[20]; float* out; unsigned char* ws; int ph_lo, ph_hi; };

typedef float f32x2_t __attribute__((ext_vector_type(2)));
typedef __bf16 bf16x2_t __attribute__((ext_vector_type(2)));
__device__ __forceinline__ unsigned cvt_pk_bf16(float lo, float hi) { const f32x2_t v = {lo, hi}; const bf16x2_t b = __builtin_convertvector(v, bf16x2_t); return __builtin_bit_cast(unsigned, b); }
__device__ __forceinline__ bf16_t f2bf_sw(float f) { return (bf16_t)(cvt_pk_bf16(f, f) & 0xffffu); }
__device__ __forceinline__ float bf_lo(unsigned w) { return __uint_as_float(w << 16); }
__device__ __forceinline__ float bf_hi(unsigned w) { return __uint_as_float(w & 0xffff0000u); }
__device__ __forceinline__ u32x4 pack8(const f32x4 a, const f32x4 b) { u32x4 w; w.x = cvt_pk_bf16(a[0], a[1]); w.y = cvt_pk_bf16(a[2], a[3]); w.z = cvt_pk_bf16(b[0], b[1]); w.w = cvt_pk_bf16(b[2], b[3]); return w; }
__device__ __forceinline__ float row_rstd(const float* part, int r) {
    const f32x4* p = (const f32x4*)(part + (size_t)r * 16);
    const f32x4 s = (p[0] + p[1]) + (p[2] + p[3]);
    return rsqrtf(((s[0] + s[1]) + (s[2] + s[3])) * (1.0f / 1024.0f) + 1e-5f);
}
__device__ __forceinline__ float xsum_16_32(float x) { x += __shfl_xor(x, 16); x += __shfl_xor(x, 32); return x; }
__device__ __forceinline__ float xmax_16_32(float x) { x = fmaxf(x, __shfl_xor(x, 16)); x = fmaxf(x, __shfl_xor(x, 32)); return x; }
__device__ __forceinline__ void rows_rstd(const float* part, int row0, int fq, float (&rs)[2][4]) {
    f32x4 q[2][4];
#pragma unroll
    for (int ai = 0; ai < 2; ++ai)
#pragma unroll
        for (int m = 0; m < 4; ++m) q[ai][m] = ((const f32x4*)(part + (size_t)(row0 + ai * 128 + m * 16) * 16))[fq];
#pragma unroll
    for (int ai = 0; ai < 2; ++ai)
#pragma unroll
        for (int m = 0; m < 4; ++m) {
            float t = (q[ai][m][0] + q[ai][m][1]) + (q[ai][m][2] + q[ai][m][3]);
            t = xsum_16_32(t);
            rs[ai][m] = rsqrtf(t * (1.0f / 1024.0f) + 1e-5f);
        }
}
__device__ __forceinline__ float fast_rcp(float x) { return __builtin_amdgcn_rcpf(x); }
__device__ __forceinline__ float sigmoid_f(float g) { return fast_rcp(1.0f + __builtin_amdgcn_exp2f(g * -LOG2E)); }
__device__ __forceinline__ float silu_f(float g) { return g * sigmoid_f(g); }

namespace pg8 {
constexpr int BM = 256, BK = 64, HALF = 128, HTB = HALF * BK * 2, NXCD = 8, WGM = 8;
__device__ __forceinline__ int lds_byte(int r, int c) { const int st = (r >> 4) * 2 + (c >> 5), rr = r & 15, cc = c & 31, ob = rr * 64 + cc * 2; return st * 1024 + (ob ^ (((ob >> 9) & 1) << 5)); }
__device__ __forceinline__ void stage_rc(int b, int& R, int& C) { const int st = b / 1024, sb = b % 1024, swz = sb ^ (((sb >> 9) & 1) << 5); R = (st >> 1) * 16 + swz / 64; C = (st & 1) * 32 + (swz % 64) / 2; }
__device__ __forceinline__ int perm32(int rho) { const int n = rho >> 4, i = rho & 15; return 8 * (i >> 2) + 4 * n + (i & 3); }
struct Unit { int pm, pn, ar; };
struct Gemm { const bf16_t* A; const bf16_t* Bt; int lda, K; };
struct StaticOrder {
    int nM, nN, nwg, G, c;
    __device__ void init(int M, int N, int G_, int c_) { nM = M / BM; nN = N / BM; nwg = nM * nN; G = G_; c = c_; }
    __device__ bool next(int i, Unit& u) const {
        const long L = (long)i * G + c; if (L >= nwg) return false;
        int wgid = (int)L; { const int q = nwg / NXCD, r = nwg % NXCD, xcd = wgid % NXCD, off = wgid / NXCD; wgid = (xcd < r ? xcd * (q + 1) : r * (q + 1) + (xcd - r) * q) + off; }
        const int nig = WGM * nN, gid = wgid / nig, fm = gid * WGM, gsz = (nM - fm) < WGM ? (nM - fm) : WGM;
        u.pm = fm + ((wgid % nig) % gsz); u.pn = (wgid % nig) / gsz; u.ar = 0; return true;
    }
};
struct CmpOrder {
    int G, c;
    __device__ bool next(int i, Unit& u) const { const int L = i * G + c; if (L >= 128) return false; u.pm = L >> 1; u.ar = L & 1; u.pn = (u.pm >> 5) * 2 + (L & 1); return true; }
};

struct GateOrder {
    int G, c;
    __device__ bool next(int i, Unit& u) const { const int L = i * G + c; if (L >= 128) return false; u.pm = L; u.pn = 10; u.ar = 0; return true; }
};
template <class Epi, class Sched>
__device__ __forceinline__ void gemm_phase(LAS unsigned char* lds, const Gemm g, const Sched& S, const Epi& E) {
    const int tid = threadIdx.x, wid = __builtin_amdgcn_readfirstlane(tid >> 6), lane = tid & 63, wr = wid >> 2, wc = wid & 3, fr = lane & 15, fq = lane >> 4;
    const int K = g.K, nt = K / BK;
    unsigned voffA[2], voffB[2];
#pragma unroll
    for (int i = 0; i < 2; ++i) { int R, C; stage_rc(tid * 16 + i * 8192, R, C); const int Rb = (R & ~31) + perm32(R & 31);
        voffA[i] = (unsigned)(R * g.lda + C) * 2u; voffB[i] = (unsigned)(Rb * K + C) * 2u; }
    const size_t kstep = (size_t)(BK * 2);
    const size_t hstepA = (size_t)HALF * g.lda * 2, hstepB = (size_t)HALF * K * 2;
    const size_t tstepA = 2 * hstepA, tstepB = 2 * hstepB;
    const unsigned ldsw = (unsigned)wid * 1024u;
    const int aoff = lds_byte(wr * 64 + fr, fq * 8), boff = lds_byte(wc * 32 + fr, fq * 8);
#define PG8_SA(b, h) (((b) * 2 + (h)) * HTB)
#define PG8_SB(b, h) ((4 + (b) * 2 + (h)) * HTB)
#define PG8_STAGE(bufoff, gbase, voff) do { _Pragma("unroll") for (int _i = 0; _i < 2; ++_i) \
        __builtin_amdgcn_global_load_lds((const unsigned*)((const char*)(gbase) + (voff)[_i]), (LAS unsigned*)(lds + (bufoff) + ldsw + _i * 8192), 16, 0, 0); } while (0)
#define PG8_LDA(dst, b, h) do { _Pragma("unroll") for (int m = 0; m < 4; ++m) _Pragma("unroll") for (int k = 0; k < 2; ++k) dst[m][k] = *(const LAS bf16x8*)(lds + PG8_SA(b, h) + aoff + m * 2048 + k * 1024); } while (0)
#define PG8_LDB(dst, b, h) do { _Pragma("unroll") for (int n = 0; n < 2; ++n) _Pragma("unroll") for (int k = 0; k < 2; ++k) dst[n][k] = *(const LAS bf16x8*)(lds + PG8_SB(b, h) + boff + n * 2048 + k * 1024); } while (0)
#define PG8_MMA(ai, bj, At, Bt) do { __builtin_amdgcn_s_setprio(1); _Pragma("unroll") for (int m = 0; m < 4; ++m) _Pragma("unroll") for (int n = 0; n < 2; ++n) _Pragma("unroll") for (int k = 0; k < 2; ++k) \
        acc[ai][bj][m][n] = __builtin_amdgcn_mfma_f32_16x16x32_bf16(Bt[n][k], At[m][k], acc[ai][bj][m][n], 0, 0, 0); __builtin_amdgcn_s_setprio(0); } while (0)
#define PG8_WAIT_V(n) asm volatile("s_waitcnt vmcnt(" #n ")" ::: "memory")
#define PG8_WAIT_L(n) asm volatile("s_waitcnt lgkmcnt(" #n ")" ::: "memory")
#define PG8_BAR __builtin_amdgcn_s_barrier()
#define PG8_SCHED __builtin_amdgcn_sched_barrier(0)
    Unit cur, nxt; int ui = 0;
    if (!S.next(0, cur)) return;
    f32x4 acc[2][2][4][2];
#pragma unroll
    for (int a = 0; a < 2; ++a)
#pragma unroll
        for (int b = 0; b < 2; ++b)
#pragma unroll
            for (int m = 0; m < 4; ++m)
#pragma unroll
                for (int n = 0; n < 2; ++n) acc[a][b][m][n] = (f32x4){0.f, 0.f, 0.f, 0.f};
    bf16x8 At[4][2], B0[2][2], B1[2][2];
    const char* cA = (const char*)g.A + (size_t)cur.pm * tstepA + (size_t)cur.ar * g.lda * 2; const char* cB = (const char*)g.Bt + (size_t)cur.pn * tstepB;
    LAS unsigned char* rsimg = lds + 131072 + wr * 8192;
    if constexpr (Epi::NEEDS_RS) E.pre(cur, rsimg, wid, wr, lane);
    PG8_STAGE(PG8_SB(0, 0), cB, voffB); PG8_STAGE(PG8_SA(0, 0), cA, voffA); PG8_STAGE(PG8_SB(0, 1), cB + hstepB, voffB); PG8_STAGE(PG8_SA(0, 1), cA + hstepA, voffA);
    if (wr == 1) PG8_BAR;
    PG8_WAIT_V(4); PG8_BAR;
    PG8_STAGE(PG8_SB(1, 0), cB + kstep, voffB); PG8_STAGE(PG8_SA(1, 0), cA + kstep, voffA); PG8_STAGE(PG8_SB(1, 1), cB + hstepB + kstep, voffB);
    PG8_WAIT_V(6); PG8_BAR;
    for (;;) {
        const bool has_next = S.next(ui + 1, nxt);
        const char* nA = has_next ? (const char*)g.A + (size_t)nxt.pm * tstepA + (size_t)nxt.ar * g.lda * 2 : cA; const char* nB = has_next ? (const char*)g.Bt + (size_t)nxt.pn * tstepB : cB;
        for (int t = 0; t < nt; t += 2) {
            const bool last = (t == nt - 2);
            const char* a1 = cA + (size_t)(t + 1) * kstep;
            const char* a2 = last ? nA : cA + (size_t)(t + 2) * kstep; const char* b2 = last ? nB : cB + (size_t)(t + 2) * kstep;
            const char* a3 = a2 + kstep; const char* b3 = b2 + kstep;
            PG8_LDB(B0, 0, 0); PG8_SCHED; PG8_LDA(At, 0, 0); PG8_STAGE(PG8_SA(1, 1), a1 + hstepA, voffA);
            PG8_WAIT_L(8); PG8_BAR; PG8_WAIT_L(0); PG8_MMA(0, 0, At, B0); PG8_BAR; PG8_SCHED;
            PG8_LDB(B1, 0, 1); PG8_STAGE(PG8_SB(0, 0), b2, voffB);
            PG8_BAR; PG8_WAIT_L(0); PG8_MMA(0, 1, At, B1); PG8_BAR;
            PG8_LDA(At, 0, 1); PG8_STAGE(PG8_SA(0, 0), a2, voffA);
            PG8_BAR; PG8_WAIT_L(0); PG8_MMA(1, 0, At, B0); PG8_BAR; PG8_SCHED;
            PG8_STAGE(PG8_SB(0, 1), b2 + hstepB, voffB);
            PG8_WAIT_V(6); PG8_BAR; PG8_MMA(1, 1, At, B1); PG8_BAR;
            PG8_LDB(B0, 1, 0); PG8_SCHED; PG8_LDA(At, 1, 0); PG8_STAGE(PG8_SA(0, 1), a2 + hstepA, voffA);
            PG8_WAIT_L(8); PG8_BAR; PG8_WAIT_L(0); PG8_MMA(0, 0, At, B0); PG8_BAR; PG8_SCHED;
            PG8_LDB(B1, 1, 1); PG8_STAGE(PG8_SB(1, 0), b3, voffB);
            PG8_BAR; PG8_WAIT_L(0); PG8_MMA(0, 1, At, B1); PG8_BAR;
            PG8_LDA(At, 1, 1); PG8_STAGE(PG8_SA(1, 0), a3, voffA);
            PG8_BAR; PG8_WAIT_L(0); PG8_MMA(1, 0, At, B0); PG8_BAR; PG8_SCHED;
            PG8_STAGE(PG8_SB(1, 1), b3 + hstepB, voffB);
            PG8_WAIT_V(6); PG8_BAR; PG8_MMA(1, 1, At, B1); PG8_BAR;
        }
        if constexpr (Epi::NEEDS_RS) {
            float rsa[2][4];
            {
                f32x4 q[2][4];
#pragma unroll
                for (int ai = 0; ai < 2; ++ai)
#pragma unroll
                    for (int m = 0; m < 4; ++m) q[ai][m] = *(const LAS f32x4*)(rsimg + (ai * 4 + m) * 1024 + fq * 256 + fr * 16);
#pragma unroll
                for (int ai = 0; ai < 2; ++ai)
#pragma unroll
                    for (int m = 0; m < 4; ++m) { const float t4 = xsum_16_32((q[ai][m][0] + q[ai][m][1]) + (q[ai][m][2] + q[ai][m][3])); rsa[ai][m] = rsqrtf(t4 * (1.0f / 1024.0f) + 1e-5f); }
                asm volatile("s_waitcnt lgkmcnt(0)" ::: "memory"); PG8_BAR; asm volatile("" ::: "memory");
                if (has_next) E.pre(nxt, rsimg, wid, wr, lane);
            }
            E(acc, cur, wr, wc, fr, fq, rsa);
        } else E(acc, cur, wr, wc, fr, fq);
        if (!has_next) break;
#pragma unroll
        for (int a = 0; a < 2; ++a)
#pragma unroll
            for (int b = 0; b < 2; ++b)
#pragma unroll
                for (int m = 0; m < 4; ++m)
#pragma unroll
                    for (int n = 0; n < 2; ++n) acc[a][b][m][n] = (f32x4){0.f, 0.f, 0.f, 0.f};
        cur = nxt; cA = nA; cB = nB; ++ui;
    }
    PG8_WAIT_V(0);
    if (wr == 0) PG8_BAR;
    PG8_BAR;
#undef PG8_SA
#undef PG8_SB
#undef PG8_STAGE
#undef PG8_LDA
#undef PG8_LDB
#undef PG8_MMA
#undef PG8_WAIT_V
#undef PG8_WAIT_L
#undef PG8_BAR
#undef PG8_SCHED
}
}
using pg8::Unit;
typedef f32x4 AccT[2][2][4][2];

struct EpiWin {
    const float* part; bf16_t* cv; bf16_t* bg;
        static constexpr bool NEEDS_RS = true;
    __device__ __forceinline__ void pre(const Unit& u, LAS unsigned char* img, int wid, int wr, int lane) const {
#pragma unroll
        for (int k = 0; k < 2; ++k) {
            const int L = k * 4096 + (wid & 3) * 1024 + lane * 16, gq = L >> 10, c = (L >> 8) & 3, rr = (L >> 4) & 15, hl = gq * 16 + rr;
            const int row = u.pm * 256 + (hl >> 6) * 128 + wr * 64 + (hl & 63);
            __builtin_amdgcn_global_load_lds((const unsigned*)(part + (size_t)row * 16 + c * 4), (LAS unsigned*)(img + k * 4096 + (wid & 3) * 1024), 16, 0, 0);
        }
    }
    __device__ __forceinline__ void operator()(const AccT& acc, const Unit& u, int wr, int wc, int fr, int fq, const float (&rsa)[2][4]) const {
        const int row0 = u.pm * 256 + wr * 64 + fr, cbase = wc * 32 + 8 * fq;
#pragma unroll
        for (int ai = 0; ai < 2; ++ai)
#pragma unroll
            for (int m = 0; m < 4; ++m) {
                const int r = row0 + ai * 128 + m * 16; const float rs = rsa[ai][m];
                if (u.pn < 8) { const float rs2 = rs * rs;
                    *(u32x4*)(cv + (size_t)r * 1024 + u.pn * 128 + cbase) = pack8(acc[ai][0][m][0] * acc[ai][1][m][0] * rs2, acc[ai][0][m][1] * acc[ai][1][m][1] * rs2);
                } else {
#pragma unroll
                    for (int bj = 0; bj < 2; ++bj) *(u32x4*)(bg + (size_t)r * 1024 + (u.pn - 8) * 256 + bj * 128 + cbase) = pack8(acc[ai][bj][m][0] * rs, acc[ai][bj][m][1] * rs);
                }
            }
    }
};
struct EpiRes {
    static constexpr bool NEEDS_RS = false;
    const float* resid; float* hout; bf16_t* hb; float* part_out;
    __device__ __forceinline__ void operator()(const AccT& acc, const Unit& u, int wr, int wc, int fr, int fq) const {
        const int row0 = u.pm * 256 + wr * 64 + fr, cbase = wc * 32 + 8 * fq;
#pragma unroll
        for (int ai = 0; ai < 2; ++ai) {
          f32x4 rv[4][2][2];
#pragma unroll
          for (int m = 0; m < 4; ++m)
#pragma unroll
              for (int bj = 0; bj < 2; ++bj) { const size_t off = (size_t)(row0 + ai * 128 + m * 16) * 1024 + u.pn * 256 + bj * 128 + cbase;
                  rv[m][bj][0] = *(const f32x4*)(resid + off); rv[m][bj][1] = *(const f32x4*)(resid + off + 4); }
#pragma unroll
            for (int m = 0; m < 4; ++m) {
                const int r = row0 + ai * 128 + m * 16; float ss = 0.f;
#pragma unroll
                for (int bj = 0; bj < 2; ++bj) {
                    const size_t off = (size_t)r * 1024 + u.pn * 256 + bj * 128 + cbase;
                    const f32x4 v0 = rv[m][bj][0] + acc[ai][bj][m][0], v1 = rv[m][bj][1] + acc[ai][bj][m][1];
                    *(f32x4*)(hout + off) = v0; *(f32x4*)(hout + off + 4) = v1;
                    if (hb) *(u32x4*)(hb + off) = pack8(v0, v1);
                    ss += (v0[0] * v0[0] + v0[1] * v0[1]) + (v0[2] * v0[2] + v0[3] * v0[3]) + (v1[0] * v1[0] + v1[1] * v1[1]) + (v1[2] * v1[2] + v1[3] * v1[3]);
                }
                ss = xsum_16_32(ss);
                if (fq == 0) part_out[(size_t)r * 16 + u.pn * 4 + wc] = ss;
            }
        }
    }
};
struct EpiResB {
    static constexpr bool NEEDS_RS = false;
    bf16_t* hb; float* part_out;
    __device__ __forceinline__ void operator()(const AccT& acc, const Unit& u, int wr, int wc, int fr, int fq) const {
        const int row0 = u.pm * 256 + wr * 64 + fr, cbase = wc * 32 + 8 * fq;
#pragma unroll
        for (int ai = 0; ai < 2; ++ai) {
            u32x4 rv[4][2];
#pragma unroll
            for (int m = 0; m < 4; ++m)
#pragma unroll
                for (int bj = 0; bj < 2; ++bj) rv[m][bj] = *(const u32x4*)(hb + (size_t)(row0 + ai * 128 + m * 16) * 1024 + u.pn * 256 + bj * 128 + cbase);
#pragma unroll
            for (int m = 0; m < 4; ++m) {
                const int r = row0 + ai * 128 + m * 16; float ss = 0.f;
#pragma unroll
                for (int bj = 0; bj < 2; ++bj) {
                    const u32x4 w = rv[m][bj];
                    const f32x4 v0 = (f32x4){bf_lo(w.x), bf_hi(w.x), bf_lo(w.y), bf_hi(w.y)} + acc[ai][bj][m][0];
                    const f32x4 v1 = (f32x4){bf_lo(w.z), bf_hi(w.z), bf_lo(w.w), bf_hi(w.w)} + acc[ai][bj][m][1];
                    *(u32x4*)(hb + (size_t)r * 1024 + u.pn * 256 + bj * 128 + cbase) = pack8(v0, v1);
                    ss += (v0[0] * v0[0] + v0[1] * v0[1]) + (v0[2] * v0[2] + v0[3] * v0[3]) + (v1[0] * v1[0] + v1[1] * v1[1]) + (v1[2] * v1[2] + v1[3] * v1[3]);
                }
                ss = xsum_16_32(ss);
                if (fq == 0) part_out[(size_t)r * 16 + u.pn * 4 + wc] = ss;
            }
        }
    }
};
struct EpiGu {
    const float* part; bf16_t* hid;
        static constexpr bool NEEDS_RS = true;
    __device__ __forceinline__ void pre(const Unit& u, LAS unsigned char* img, int wid, int wr, int lane) const {
#pragma unroll
        for (int k = 0; k < 2; ++k) {
            const int L = k * 4096 + (wid & 3) * 1024 + lane * 16, gq = L >> 10, c = (L >> 8) & 3, rr = (L >> 4) & 15, hl = gq * 16 + rr;
            const int row = u.pm * 256 + (hl >> 6) * 128 + wr * 64 + (hl & 63);
            __builtin_amdgcn_global_load_lds((const unsigned*)(part + (size_t)row * 16 + c * 4), (LAS unsigned*)(img + k * 4096 + (wid & 3) * 1024), 16, 0, 0);
        }
    }
    __device__ __forceinline__ void operator()(const AccT& acc, const Unit& u, int wr, int wc, int fr, int fq, const float (&rsa)[2][4]) const {
        const int row0 = u.pm * 256 + wr * 64 + fr, cbase = wc * 32 + 8 * fq;
#pragma unroll
        for (int ai = 0; ai < 2; ++ai)
#pragma unroll
            for (int m = 0; m < 4; ++m) {
                const int r = row0 + ai * 128 + m * 16; const float rs = rsa[ai][m];
                f32x4 o[2];
#pragma unroll
                for (int n = 0; n < 2; ++n)
#pragma unroll
                    for (int j = 0; j < 4; ++j) { const float gg = acc[ai][0][m][n][j] * rs, uu = acc[ai][1][m][n][j] * rs; o[n][j] = silu_f(gg) * uu; }
                *(u32x4*)(hid + (size_t)r * FF + u.pn * 128 + cbase) = pack8(o[0], o[1]);
            }
    }
};
struct EpiKvqg {
    const float* part; unsigned char* ws;
        static constexpr bool NEEDS_RS = true;
    __device__ __forceinline__ void pre(const Unit& u, LAS unsigned char* img, int wid, int wr, int lane) const {
#pragma unroll
        for (int k = 0; k < 2; ++k) {
            const int L = k * 4096 + (wid & 3) * 1024 + lane * 16, gq = L >> 10, c = (L >> 8) & 3, rr = (L >> 4) & 15, hl = gq * 16 + rr;
            const int row = u.pm * 256 + (hl >> 6) * 128 + wr * 64 + (hl & 63);
            __builtin_amdgcn_global_load_lds((const unsigned*)(part + (size_t)row * 16 + c * 4), (LAS unsigned*)(img + k * 4096 + (wid & 3) * 1024), 16, 0, 0);
        }
    }
    __device__ __forceinline__ void operator()(const AccT& acc, const Unit& u, int wr, int wc, int fr, int fq, const float (&rsa)[2][4]) const {
        const int row0 = u.pm * 256 + wr * 64 + fr, cbase = wc * 32 + 8 * fq;
#pragma unroll
        for (int ai = 0; ai < 2; ++ai)
#pragma unroll
            for (int m = 0; m < 4; ++m) {
                const int r = row0 + ai * 128 + m * 16; const float rs = rsa[ai][m];
                const int b = r >> 13, s = r & 8191;
#pragma unroll
                for (int bj = 0; bj < 2; ++bj) {
                    const int col = bj * 128 + cbase;
                    const f32x4 v0 = acc[ai][bj][m][0] * rs, v1 = acc[ai][bj][m][1] * rs;
                    if (u.pn < 6) {
                        const int gi = col >> 6, d = col & 63, bgi = b * 4 + gi;
                        if (u.pn < 2) { *(u32x4*)((bf16_t*)(ws + WS_CMPRAW) + ((size_t)(u.pn * 16 + bgi) * SEQ + s) * 64 + d) = pack8(v0, v1); }
                        else if (u.pn == 2 || u.pn == 4) { *(u32x4*)((bf16_t*)(ws + (u.pn == 2 ? WS_KSLC : WS_KWIN)) + ((size_t)bgi * SEQ + s) * 64 + d) = pack8(v0, v1); }
                        else { bf16_t* vt = (bf16_t*)(ws + (u.pn == 3 ? WS_VSLC : WS_VWIN)) + ((size_t)(bgi * 128 + (s >> 6)) * 64 + d) * 64 + (s & 63);
                            const u32x4 w = pack8(v0, v1);
                            vt[0 * 64] = (bf16_t)(w.x & 0xffff); vt[1 * 64] = (bf16_t)(w.x >> 16); vt[2 * 64] = (bf16_t)(w.y & 0xffff); vt[3 * 64] = (bf16_t)(w.y >> 16);
                            vt[4 * 64] = (bf16_t)(w.z & 0xffff); vt[5 * 64] = (bf16_t)(w.z >> 16); vt[6 * 64] = (bf16_t)(w.w & 0xffff); vt[7 * 64] = (bf16_t)(w.w >> 16); }
                    } else if (u.pn < 10) {
                        const float qs = 0.125f * LOG2E;
                        *(u32x4*)((bf16_t*)(ws + WS_Q) + (size_t)r * 1024 + (u.pn - 6) * 256 + col) = pack8(v0 * qs, v1 * qs);
                    } else {
                        if (col < 48) { float* gp = (float*)(ws + WS_GATES) + (size_t)r * 48 + col;
                            f32x4 a, c2;
#pragma unroll
                            for (int j = 0; j < 4; ++j) { a[j] = sigmoid_f(v0[j]); c2[j] = sigmoid_f(v1[j]); }
                            *(f32x4*)gp = a; *(f32x4*)(gp + 4) = c2; }
                    }
                }
            }
    }
};
struct EpiCmp {
    static constexpr bool NEEDS_RS = false;
    bf16_t* pbuf;
    __device__ __forceinline__ void operator()(const AccT& acc, const Unit& u, int wr, int wc, int fr, int fq) const {
        const int row0 = u.pm * 256 + wr * 64 + fr, cbase = wc * 32 + 8 * fq;
        bf16_t* base = pbuf + (size_t)(u.pn & 1) * 16384 * 256;
#pragma unroll
        for (int ai = 0; ai < 2; ++ai)
#pragma unroll
            for (int m = 0; m < 4; ++m) {
                const int r = row0 + ai * 128 + m * 16;
#pragma unroll
                for (int bj = 0; bj < 2; ++bj) *(u32x4*)(base + (size_t)r * 256 + bj * 128 + cbase) = pack8(acc[ai][bj][m][0], acc[ai][bj][m][1]);
            }
    }
};

__device__ __forceinline__ void transpose_item(const float* W, int K, int Nsrc, bf16_t* dst, int kind, const float* gain, int item, LAS float* scr, int nN64) {
    const int tid = threadIdx.x;
    const int kb = item / nN64, nb = item % nN64, k0 = kb * 64, nd0 = nb * 64;
    int ns0 = nd0;
    if (kind == 1) { if (nd0 < 2048) { const int pn = nd0 >> 8, half = (nd0 >> 7) & 1, c = nd0 & 127; ns0 = 1024 + half * 1024 + pn * 128 + c; } else ns0 = nd0 - 2048; }
    else if (kind == 2) { const int pn = nd0 >> 8, half = (nd0 >> 7) & 1, c = nd0 & 127; ns0 = half * FF + pn * 128 + c; }
    const int kk = tid >> 4, n4 = (tid & 15) * 4;
#pragma unroll
    for (int i = 0; i < 2; ++i) {
        const int k = k0 + kk + 32 * i;
        f32x4 v = (f32x4){0.f, 0.f, 0.f, 0.f};
        if (ns0 + n4 < Nsrc) v = __builtin_nontemporal_load((const f32x4*)(W + (size_t)k * Nsrc + ns0 + n4));
        if (gain) v = v * gain[k];
        LAS float* sp = scr + (kk + 32 * i) * 65 + n4;
        sp[0] = v[0]; sp[1] = v[1]; sp[2] = v[2]; sp[3] = v[3];
    }
    __syncthreads();
    const int n = tid >> 3, kc = (tid & 7) * 8;
    const LAS float* s = scr + kc * 65 + n;
    u32x4 o; o.x = cvt_pk_bf16(s[0], s[65]); o.y = cvt_pk_bf16(s[2 * 65], s[3 * 65]); o.z = cvt_pk_bf16(s[4 * 65], s[5 * 65]); o.w = cvt_pk_bf16(s[6 * 65], s[7 * 65]);
    *(u32x4*)(dst + (size_t)(nd0 + n) * K + k0 + kc) = o;
    __syncthreads();
}
__device__ __forceinline__ void prep_phase(const Params& p, LAS unsigned char* lds) {
    LAS float* scr = (LAS float*)lds;
    unsigned char* ws = p.ws;
    const int G = gridDim.x, bx = blockIdx.x, tid = threadIdx.x, lane = tid & 63, wv = tid >> 6;
    constexpr int NW = 15;
    const float* srcs[NW] = {p.in[2], p.in[4], p.in[17], p.in[17] + (size_t)1024 * 5632, p.in[18], p.in[18] + (size_t)FF * 1024, p.in[6], p.in[14], p.in[8], p.in[11], p.in[15], p.in[9], p.in[12],
                             p.in[8] + (size_t)1024 * 256, p.in[11] + (size_t)1024 * 256};
    const int Ks[NW] = {1024, 1024, 1024, 1024, FF, FF, 1024, 1024, 1024, 1024, 1024, 256, 256, 1024, 1024};
    const int Nsrcs[NW] = {3072, 1024, 5632, 5632, 1024, 1024, 1536, 1072, 256, 256, 1024, 64, 64, 256, 256};
    const int Ndsts[NW] = {3072, 1024, 5632, 5632, 1024, 1024, 1536, 1280, 256, 256, 1024, 64, 64, 256, 256};
    const size_t dsts[NW] = {WS_WIN, WS_WOUT, WS_WGU0, WS_WGU1, WS_WDN0, WS_WDN1, WS_WKVQG, WS_WKVQG + (size_t)1536 * 1024 * 2, WS_WC1, WS_WC1 + (size_t)2 * 256 * 1024 * 2, WS_WO, WS_WC2, WS_WC2 + 64 * 256 * 2,
                             WS_WC1 + (size_t)1 * 256 * 1024 * 2, WS_WC1 + (size_t)3 * 256 * 1024 * 2};
    const int kinds[NW] = {1, 0, 2, 2, 0, 0, 0, 0, 0, 0, 0, 0, 0, 0, 0};
    const float* gains[NW] = {p.in[1], nullptr, p.in[16], p.in[16] + 1024, nullptr, nullptr, p.in[5], p.in[13], nullptr, nullptr, nullptr, nullptr, nullptr, nullptr, nullptr};
    int base = 0;
#pragma unroll
    for (int wi = 0; wi < NW; ++wi) {
        const int nN64 = Ndsts[wi] / 64, nitems = (Ks[wi] / 64) * nN64;
        int first = (bx - base % G + G) % G;
        for (int it = first; it < nitems; it += G) transpose_item(srcs[wi], Ks[wi], Nsrcs[wi], (bf16_t*)(ws + dsts[wi]), kinds[wi], gains[wi], it, scr, nN64);
        base += nitems;
    }
    {
        const float* x = p.in[0]; bf16_t* hb = (bf16_t*)(ws + WS_HB); float* part = (float*)(ws + WS_PART);
        for (int r = bx * 8 + wv; r < T; r += G * 8) {
            const f32x4* xr = (const f32x4*)(x + (size_t)r * 1024);
            float ss = 0.f;
#pragma unroll
            for (int j = 0; j < 2; ++j) {
                const f32x4 a = __builtin_nontemporal_load(xr + j * 128 + lane * 2), b = __builtin_nontemporal_load(xr + j * 128 + lane * 2 + 1);
                ss += (a[0] * a[0] + a[1] * a[1]) + (a[2] * a[2] + a[3] * a[3]) + (b[0] * b[0] + b[1] * b[1]) + (b[2] * b[2] + b[3] * b[3]);
                *(u32x4*)(hb + (size_t)r * 1024 + j * 512 + lane * 8) = pack8(a, b);
            }
#pragma unroll
            for (int o = 1; o < 64; o <<= 1) ss += __shfl_xor(ss, o);
            if (lane < 16) part[(size_t)r * 16 + lane] = (lane == 0) ? ss : 0.f;
        }
    }
    if (bx == 0) { unsigned* bw = (unsigned*)(ws + WS_BAR); for (int i = tid; i < 3456; i += 512) __hip_atomic_store(bw + i, 0u, __ATOMIC_RELAXED, __HIP_MEMORY_SCOPE_AGENT); }
    if (bx == 1 && tid < 17) __hip_atomic_store((unsigned*)(ws + WS_KMAX) + tid, 0u, __ATOMIC_RELAXED, __HIP_MEMORY_SCOPE_AGENT);
    if (bx < 2 && tid < 256) {
        const float* pe = p.in[bx == 0 ? 7 : 10]; const float* w1 = p.in[bx == 0 ? 8 : 11];
        float a = 0.f;
        for (int i = 0; i < 2048; ++i) a += pe[i] * w1[(size_t)i * 256 + tid];
        ((float*)(ws + WS_CBIAS))[bx * 256 + tid] = a;
    }
}

__device__ __forceinline__ void conv_phase(const Params& p) {
    unsigned char* ws = p.ws;
    const bf16_t* cv = (const bf16_t*)(ws + WS_CV); const bf16_t* bg = (const bf16_t*)(ws + WS_BG); bf16_t* uo = (bf16_t*)(ws + WS_U);
    const float* cw = p.in[3];
    const size_t total = (size_t)T * 128, stride = (size_t)gridDim.x * 512;
    for (size_t idx = (size_t)blockIdx.x * 512 + threadIdx.x; idx < total; idx += stride) {
        const int t = (int)(idx >> 7), c8 = (int)(idx & 127) * 8, s = t & 8191;
        const u32x4 z = (u32x4){0u, 0u, 0u, 0u};
        const u32x4 x2 = *(const u32x4*)(cv + (size_t)t * 1024 + c8);
        const u32x4 x1 = s >= 1 ? *(const u32x4*)(cv + (size_t)(t - 1) * 1024 + c8) : z;
        const u32x4 x0 = s >= 2 ? *(const u32x4*)(cv + (size_t)(t - 2) * 1024 + c8) : z;
        const u32x4 bb = *(const u32x4*)(bg + (size_t)t * 1024 + c8);
        const f32x4 w0a = *(const f32x4*)(cw + c8), w0b = *(const f32x4*)(cw + c8 + 4);
        const f32x4 w1a = *(const f32x4*)(cw + 1024 + c8), w1b = *(const f32x4*)(cw + 1024 + c8 + 4);
        const f32x4 w2a = *(const f32x4*)(cw + 2048 + c8), w2b = *(const f32x4*)(cw + 2048 + c8 + 4);
        f32x4 oa, ob;
#pragma unroll
        for (int j = 0; j < 2; ++j) {
            oa[2 * j] = bf_lo(bb[j]) * (w0a[2 * j] * bf_lo(x0[j]) + w1a[2 * j] * bf_lo(x1[j]) + w2a[2 * j] * bf_lo(x2[j]));
            oa[2 * j + 1] = bf_hi(bb[j]) * (w0a[2 * j + 1] * bf_hi(x0[j]) + w1a[2 * j + 1] * bf_hi(x1[j]) + w2a[2 * j + 1] * bf_hi(x2[j]));
            ob[2 * j] = bf_lo(bb[2 + j]) * (w0b[2 * j] * bf_lo(x0[2 + j]) + w1b[2 * j] * bf_lo(x1[2 + j]) + w2b[2 * j] * bf_lo(x2[2 + j]));
            ob[2 * j + 1] = bf_hi(bb[2 + j]) * (w0b[2 * j + 1] * bf_hi(x0[2 + j]) + w1b[2 * j + 1] * bf_hi(x1[2 + j]) + w2b[2 * j + 1] * bf_hi(x2[2 + j]));
        }
        *(u32x4*)(uo + (size_t)t * 1024 + c8) = pack8(oa, ob);
    }
}

__device__ __forceinline__ void cmp2_phase(const Params& p) {
    unsigned char* ws = p.ws;
    const bf16_t* pb0 = (const bf16_t*)(ws + WS_O); const bf16_t* pb1 = pb0 + (size_t)16384 * 256; const float* cbias = (const float*)(ws + WS_CBIAS);
    const bf16_t* w2t = (const bf16_t*)(ws + WS_WC2);
    bf16_t* kcmp = (bf16_t*)(ws + WS_KCMP); bf16_t* vcmp = (bf16_t*)(ws + WS_VCMP);
    const int tid = threadIdx.x, lane = tid & 63, wv = tid >> 6, i16 = lane & 15, slab = lane >> 4;
    for (int un = blockIdx.x; un < 256; un += gridDim.x) {
        const int R0 = un * 64, set = R0 >> 13;
        const int rt = wv >> 1;
        const size_t aoff = (size_t)(R0 + 16 * rt + i16) * 256 + 8 * slab;
        u32x4 pw0[8], pw1[8]; f32x4 pba[8], pbb[8];
#pragma unroll
        for (int ks = 0; ks < 8; ++ks) { pw0[ks] = *(const u32x4*)(pb0 + aoff + 32 * ks); pw1[ks] = *(const u32x4*)(pb1 + aoff + 32 * ks);
            pba[ks] = *(const f32x4*)(cbias + set * 256 + 32 * ks + 8 * slab); pbb[ks] = *(const f32x4*)(cbias + set * 256 + 32 * ks + 8 * slab + 4); }
        f32x4 c[2] = {(f32x4){0.f, 0.f, 0.f, 0.f}, (f32x4){0.f, 0.f, 0.f, 0.f}};
        float amax = 0.f;
#pragma unroll
        for (int ks = 0; ks < 8; ++ks) {
            const u32x4 w0 = pw0[ks], w1 = pw1[ks]; const f32x4 ba = pba[ks], bb = pbb[ks];
            f32x4 h0, h1;
            h0[0] = silu_f(bf_lo(w0.x) + bf_lo(w1.x) + ba[0]); h0[1] = silu_f(bf_hi(w0.x) + bf_hi(w1.x) + ba[1]);
            h0[2] = silu_f(bf_lo(w0.y) + bf_lo(w1.y) + ba[2]); h0[3] = silu_f(bf_hi(w0.y) + bf_hi(w1.y) + ba[3]);
            h1[0] = silu_f(bf_lo(w0.z) + bf_lo(w1.z) + bb[0]); h1[1] = silu_f(bf_hi(w0.z) + bf_hi(w1.z) + bb[1]);
            h1[2] = silu_f(bf_lo(w0.w) + bf_lo(w1.w) + bb[2]); h1[3] = silu_f(bf_hi(w0.w) + bf_hi(w1.w) + bb[3]);
            const u32x4 aw = pack8(h0, h1);
            const bf16x8 a = *(const bf16x8*)&aw;
#pragma unroll
            for (int cc = 0; cc < 2; ++cc) {
                const int ct = (wv & 1) * 2 + cc;
                const bf16x8 b = *(const bf16x8*)(w2t + (size_t)set * 64 * 256 + (size_t)(16 * ct + i16) * 256 + 32 * ks + 8 * slab);
                c[cc] = __builtin_amdgcn_mfma_f32_16x16x32_bf16(a, b, c[cc], 0, 0, 0);
            }
        }
#pragma unroll
        for (int cc = 0; cc < 2; ++cc) {
            const int n = 16 * ((wv & 1) * 2 + cc) + i16;
#pragma unroll
            for (int r = 0; r < 4; ++r) {
                const int R = R0 + 16 * rt + 4 * slab + r, rr = R & 8191, bgi = rr >> 9, nn = rr & 511;
                const float v = (nn == 511) ? 0.f : c[cc][r];
                const bf16_t hv = f2bf_sw(v);
                if (set == 0) kcmp[((size_t)bgi * 512 + nn) * 64 + n] = hv;
                else vcmp[(((size_t)bgi * 8 + (nn >> 6)) * 64 + n) * 64 + (nn & 63)] = hv;
                amax = fmaxf(amax, fabsf(v));
            }
        }
        if (set == 0) {
#pragma unroll
            for (int o = 1; o < 64; o <<= 1) amax = fmaxf(amax, __shfl_xor(amax, o));
            if (lane == 0) __hip_atomic_fetch_max((unsigned*)(ws + WS_KMAX) + ((R0 & 8191) >> 9), __float_as_uint(amax), __ATOMIC_RELAXED, __HIP_MEMORY_SCOPE_AGENT);
        }
    }
}

constexpr int KP = 72;
constexpr int IMP_P = 132;
constexpr int A_K = 0, A_V = 24576, A_IMP = 49152, A_WUN = A_IMP + 64 * IMP_P * 4, A_TL = A_WUN + 128, A_SEL = A_TL + 512, A_OFIN = 86016;

template <bool MASK, int KIND>
__device__ __forceinline__ void attn_tile(const LAS bf16_t* Kb, const LAS bf16_t* Vb, const bf16x8 (&qf)[2][2], f32x4 (&O)[2][4], float (&m)[2], float (&l)[2],
                                          const float (&lb)[2], const float (&slope2)[2], const float skmul, int lo, int hi, int col, int slab, LAS float* imp_row, int jbase) {
    const int sw = (col >> 1) & 7;
    constexpr float LAZY_THR = 12.0f;
    f32x4 sc[2][4];
    float mref[2];
#pragma unroll
    for (int ct = 0; ct < 2; ++ct) {
        const float skv = slope2[ct] * skmul;
        mref[ct] = (m[ct] < -1e19f) ? 0.f : m[ct];
        const float lbr = lb[ct] - mref[ct];
#pragma unroll
        for (int st = 0; st < 4; ++st) { const float c0 = fmaf(skv, (float)(16 * st), lbr); sc[ct][st] = (f32x4){c0, c0 + skv, fmaf(skv, 2.f, c0), fmaf(skv, 3.f, c0)}; }
    }
#pragma unroll
    for (int st = 0; st < 4; ++st) {
#pragma unroll
        for (int ks = 0; ks < 2; ++ks) {
            const bf16x8 kf = *(const LAS bf16x8*)(Kb + (16 * st + col) * 64 + (((4 * ks + slab) ^ sw) << 3));
#pragma unroll
            for (int ct = 0; ct < 2; ++ct) sc[ct][st] = __builtin_amdgcn_mfma_f32_16x16x32_bf16(kf, qf[ct][ks], sc[ct][st], 0, 0, 0);
        }
        asm volatile("" ::: "memory");
    }
    if (MASK) {
        const int lo2 = lo - 4 * slab, hi2 = hi - 4 * slab;
#pragma unroll
        for (int ct = 0; ct < 2; ++ct)
#pragma unroll
            for (int st = 0; st < 4; ++st)
#pragma unroll
                for (int r = 0; r < 4; ++r) { const int kk = 16 * st + r; sc[ct][st][r] = (kk >= lo2 && kk <= hi2) ? sc[ct][st][r] : -1e30f; }
    }
    if (KIND != 2) {
        float mxl[2];
#pragma unroll
        for (int ct = 0; ct < 2; ++ct) {
            float mx = -1e30f;
#pragma unroll
            for (int st = 0; st < 4; ++st) mx = fmaxf(fmaxf(mx, fmaxf(sc[ct][st][0], sc[ct][st][1])), fmaxf(sc[ct][st][2], sc[ct][st][3]));
            mxl[ct] = mx;
        }
        const bool slow = __any((mxl[0] > LAZY_THR) || (mxl[1] > LAZY_THR) || (m[0] < -1e19f) || (m[1] < -1e19f));
        if (slow) {
#pragma unroll
            for (int ct = 0; ct < 2; ++ct) {
                const float mx = xmax_16_32(mxl[ct]);
                const float mrel = m[ct] - mref[ct];
                const float mn = fmaxf(mrel, mx);
                const float alpha = __builtin_amdgcn_exp2f(mrel - mn);
                m[ct] = mref[ct] + mn; l[ct] *= alpha;
#pragma unroll
                for (int st = 0; st < 4; ++st) sc[ct][st] = sc[ct][st] - mn;
                if (KIND == 0) {
#pragma unroll
                    for (int dt = 0; dt < 4; ++dt) O[ct][dt] = O[ct][dt] * alpha;
                }
            }
        }
    }
#pragma unroll
    for (int ct = 0; ct < 2; ++ct) {
        f32x4 sum4 = (f32x4){0.f, 0.f, 0.f, 0.f};
#pragma unroll
        for (int st = 0; st < 4; ++st) {
            f32x4 e;
#pragma unroll
            for (int r = 0; r < 4; ++r) e[r] = __builtin_amdgcn_exp2f(sc[ct][st][r]);
            if (KIND == 2) e = e * l[ct];
            sc[ct][st] = e; sum4 += e;
        }
        if (KIND != 2) l[ct] += (sum4[0] + sum4[1]) + (sum4[2] + sum4[3]);
    }
    if (KIND == 1) return;
    if (KIND == 2) {
#pragma unroll
        for (int st = 0; st < 4; ++st) {
            float g4 = (sc[0][st][0] + sc[0][st][1]) + (sc[0][st][2] + sc[0][st][3]) + (sc[1][st][0] + sc[1][st][1]) + (sc[1][st][2] + sc[1][st][3]);
            g4 += __shfl_xor(g4, 8);
            if ((col & 8) == 0) imp_row[jbase + 4 * st + slab] += g4;
        }
        asm volatile("s_waitcnt lgkmcnt(0)" ::: "memory");
#pragma unroll
        for (int st = 0; st < 4; ++st) {
            float la = sc[0][st][3] + sc[1][st][3];
            la += __shfl_xor(la, 8);
            if ((col & 8) == 0) imp_row[jbase + 4 * st + slab + 1] += la;
        }
    }
#pragma unroll
    for (int ks2 = 0; ks2 < 2; ++ks2) {
        bf16x8 pf[2];
#pragma unroll
        for (int ct = 0; ct < 2; ++ct) { const u32x4 w = pack8(sc[ct][2 * ks2], sc[ct][2 * ks2 + 1]); pf[ct] = *(const bf16x8*)&w; }
#pragma unroll
        for (int dt = 0; dt < 4; ++dt) {
            const LAS bf16_t* vrow = Vb + (16 * dt + col) * 64 + 4 * (slab & 1);
            const int vc = (4 * ks2 + (slab >> 1)) ^ sw;
            const u32x2 a0 = *(const LAS u32x2*)(vrow + (vc << 3)), a1 = *(const LAS u32x2*)(vrow + ((vc ^ 2) << 3));
            const u32x4 aw = (u32x4){a0.x, a0.y, a1.x, a1.y};
            const bf16x8 vf = *(const bf16x8*)&aw;
#pragma unroll
            for (int ct = 0; ct < 2; ++ct) O[ct][dt] = __builtin_amdgcn_mfma_f32_16x16x32_bf16(vf, pf[ct], O[ct][dt], 0, 0, 0);
            asm volatile("" ::: "memory");
        }
    }
}

__device__ __forceinline__ int sum_jg(int x) {
    x += __builtin_amdgcn_update_dpp(0, x, 0x128, 0xf, 0xf, false);
    auto a = __builtin_amdgcn_permlane16_swap((unsigned)x, (unsigned)x, false, false);
    x = (int)(a[0] + a[1]);
    auto b = __builtin_amdgcn_permlane32_swap((unsigned)x, (unsigned)x, false, false);
    return (int)(b[0] + b[1]);
}
__device__ __forceinline__ unsigned pick4(const unsigned (&a)[4], int i) { return i == 0 ? a[0] : (i == 1 ? a[1] : (i == 2 ? a[2] : a[3])); }
__device__ __forceinline__ void attn_phase(const Params& p, LAS unsigned char* lds) {
    unsigned char* ws = p.ws;
    const bf16_t* qbuf = (const bf16_t*)(ws + WS_Q); const float* gates = (const float*)(ws + WS_GATES);
    const bf16_t* kcmp = (const bf16_t*)(ws + WS_KCMP); const bf16_t* vcmp = (const bf16_t*)(ws + WS_VCMP);
    const bf16_t* kslc = (const bf16_t*)(ws + WS_KSLC); const bf16_t* vslc = (const bf16_t*)(ws + WS_VSLC);
    const bf16_t* kwin = (const bf16_t*)(ws + WS_KWIN); const bf16_t* vwin = (const bf16_t*)(ws + WS_VWIN);
    bf16_t* obuf = (bf16_t*)(ws + WS_O);
    const int tid = threadIdx.x, lane = tid & 63, w = __builtin_amdgcn_readfirstlane(tid >> 6), col = lane & 15, slab = lane >> 4, qi = lane & 7;
    LAS bf16_t* Ksm = (LAS bf16_t*)(lds + A_K); LAS bf16_t* Vsm = (LAS bf16_t*)(lds + A_V);
    LAS float* imp = (LAS float*)(lds + A_IMP); LAS unsigned* wun = (LAS unsigned*)(lds + A_WUN); LAS unsigned short* tl = (LAS unsigned short*)(lds + A_TL);
    LAS float* imp_row = imp + (8 * w + qi) * IMP_P;
    LAS unsigned* selw = (LAS unsigned*)(lds + A_SEL) + (8 * w + qi) * 4;
    const int dsrc = (tid >> 3) * 64 + ((((tid & 7) ^ ((tid >> 4) & 7))) << 3);
#define ATT_DMA(kptr, vptr, buf) do { \
        __builtin_amdgcn_global_load_lds((const unsigned*)((kptr) + dsrc), (LAS unsigned*)(lds + A_K + (buf) * 8192 + w * 1024), 16, 0, 0); \
        __builtin_amdgcn_global_load_lds((const unsigned*)((vptr) + dsrc), (LAS unsigned*)(lds + A_V + (buf) * 8192 + w * 1024), 16, 0, 0); } while (0)
#define ATT_WAIT(more) do { if (more) asm volatile("s_waitcnt vmcnt(2)" ::: "memory"); else asm volatile("s_waitcnt vmcnt(0)" ::: "memory"); \
        __builtin_amdgcn_s_barrier(); asm volatile("" ::: "memory"); } while (0)

    unsigned* qctr = (unsigned*)(ws + WS_KMAX) + 16;
    LAS int* qslot = (LAS int*)(lds + A_TL + 448);
    if (tid == 0) qslot[0] = (int)__hip_atomic_fetch_add(qctr, 1u, __ATOMIC_RELAXED, __HIP_MEMORY_SCOPE_AGENT);
    __syncthreads();
    int ui = __builtin_amdgcn_readfirstlane(qslot[0]);
    while (ui < 2048) {
        int nxt_ui = 0;
        const int qb = 127 - (ui >> 4), bgi = ui & 15, b = bgi >> 2, g = bgi & 3;
        const int ql = 8 * w + qi, t = qb * 64 + ql;
        const int tok = b * SEQ + t;
        bf16x8 qf[2][2]; float slope2[2]; int hh[2];
#pragma unroll
        for (int ct = 0; ct < 2; ++ct) {
            hh[ct] = 4 * g + 2 * ct + (col >> 3);
            slope2[ct] = exp2f(-0.5f * (float)(hh[ct] + 1)) * LOG2E;
#pragma unroll
            for (int ks = 0; ks < 2; ++ks) qf[ct][ks] = *(const bf16x8*)(qbuf + (size_t)tok * 1024 + hh[ct] * 64 + 32 * ks + 8 * slab);
        }
        for (int i = lane; i < 8 * IMP_P; i += 64) imp[8 * w * IMP_P + i] = 0.f;
        f32x4 O[2][4]; float m[2], l[2];
        LAS f32x4* ofin = (LAS f32x4*)(lds + A_OFIN) + tid;
#pragma unroll
        for (int ct = 0; ct < 2; ++ct) { m[ct] = -1e20f; l[ct] = 0.f;
#pragma unroll
            for (int dt = 0; dt < 4; ++dt) O[ct][dt] = (f32x4){0.f, 0.f, 0.f, 0.f}; }
        float lb[2]; float skmul;
        const int nkt = (4 * qb + 3 + 63) >> 6;
        const int nmax = (t - 31) >> 4;
        int nproc;
        {
            const float kinf = __uint_as_float(((const unsigned*)(ws + WS_KMAX))[bgi]) * 1.01f;
            int kneed = nkt - 1;
#pragma unroll
            for (int ct = 0; ct < 2; ++ct) {
                float qn = 0.f;
#pragma unroll
                for (int ks = 0; ks < 2; ++ks)
#pragma unroll
                    for (int e = 0; e < 8; ++e) qn += __uint_as_float(((unsigned)(unsigned short)qf[ct][ks][e] & 0x7fffu) << 16);
                qn = xsum_16_32(qn) * 1.001f;
                const float X = ((float)t - 1055.f - (170.f + 2.f * qn * kinf) / slope2[ct]) * (1.0f / 1024.0f);
                const int kn = X > 0.f ? (int)ceilf(X) : 0;
                kneed = kn < kneed ? kn : kneed;
            }
#pragma unroll
            for (int o = 1; o < 16; o <<= 1) { const int other = __shfl_xor(kneed, o); kneed = other < kneed ? other : kneed; }
            LAS int* knw = (LAS int*)(lds + A_TL + 384);
            if (lane == 0) knw[w] = kneed;
            __syncthreads();
            int ktmin = knw[0];
#pragma unroll
            for (int w2 = 1; w2 < 8; ++w2) { const int v = knw[w2]; ktmin = v < ktmin ? v : ktmin; }
            nproc = nkt - __builtin_amdgcn_readfirstlane(ktmin);
        }
        const int n1 = 2 * nproc;
        const bf16_t* kc0 = kcmp + (size_t)bgi * 512 * 64; const bf16_t* vc0 = vcmp + (size_t)bgi * 8 * 4096;
#define KT1(i) (nkt - 1 - (((i) < nproc) ? (i) : (i) - nproc))
        asm volatile("" :: "v"(qf[0][0]), "v"(qf[0][1]), "v"(qf[1][0]), "v"(qf[1][1]));
        if (tid == 0) nxt_ui = (int)atomicInc(qctr, 0xffffffffu);
        ATT_DMA(kc0 + KT1(0) * 4096, vc0 + KT1(0) * 4096, 0);
        ATT_DMA(kc0 + KT1(1) * 4096, vc0 + KT1(1) * 4096, 1);
        skmul = 16.f;
        const int nmax_min = (qb * 64 + 8 * w - 31) >> 4;
        int cb = 0;
        for (int i = 0; i < n1; ++i) {
            ATT_WAIT(i + 1 < n1);
            if (i + 2 < n1) { const int nb = cb == 0 ? 2 : cb - 1; ATT_DMA(kc0 + KT1(i + 2) * 4096, vc0 + KT1(i + 2) * 4096, nb); }
            const LAS bf16_t* Kb = Ksm + cb * 4096; const LAS bf16_t* Vb = Vsm + cb * 4096;
            cb = cb == 2 ? 0 : cb + 1;
            const int kt = KT1(i);
#pragma unroll
            for (int ct = 0; ct < 2; ++ct) lb[ct] = slope2[ct] * (16.f * (float)(64 * kt + 4 * slab) + 15.5f - (float)t);
            const int hi = nmax - 64 * kt;
            const bool cmask = (64 * kt + 63 > nmax_min);
            if (i < nproc) { if (cmask) attn_tile<true, 1>(Kb, Vb, qf, O, m, l, lb, slope2, skmul, 0, hi, col, slab, imp_row, 0);
                           else attn_tile<false, 1>(Kb, Vb, qf, O, m, l, lb, slope2, skmul, 0, 63, col, slab, imp_row, 0); }
            else {
                if (i == nproc) {
#pragma unroll
                    for (int ct = 0; ct < 2; ++ct) { float lt = xsum_16_32(l[ct]); l[ct] = lt > 0.f ? fast_rcp(lt) : 0.f; }
                }
                if (cmask) attn_tile<true, 2>(Kb, Vb, qf, O, m, l, lb, slope2, skmul, 0, hi, col, slab, imp_row, 16 * kt);
                else attn_tile<false, 2>(Kb, Vb, qf, O, m, l, lb, slope2, skmul, 0, 63, col, slab, imp_row, 16 * kt);
            }
        }
        {
#pragma unroll
            for (int ct = 0; ct < 2; ++ct) { const float g0 = gates[(size_t)tok * 48 + hh[ct] * 3 + 0];
#pragma unroll
                for (int dt = 0; dt < 4; ++dt) { ofin[(ct * 4 + dt) * 512] = O[ct][dt] * g0; O[ct][dt] = (f32x4){0.f, 0.f, 0.f, 0.f}; }
                m[ct] = -1e20f; l[ct] = 0.f; }
        }
        unsigned sel[4];
        {
            const int jg = lane >> 3;
            unsigned m16 = 0;
            if (qb - 2 <= 13) {
#pragma unroll
                for (int e = 0; e < 16; ++e) if (16 * jg + e <= qb) m16 |= 1u << e;
            } else {
                unsigned key[16];
#pragma unroll
                for (int e = 0; e < 16; ++e) { const int j = 16 * jg + e; const float v = imp_row[j]; key[e] = (j >= 1 && j <= qb - 2) ? (__float_as_uint(v) + 1u) : 0u; }
                unsigned Tt = 0;
                for (int bit = 30; bit >= 0; --bit) {
                    const unsigned cand = Tt | (1u << bit); int cnt = 0;
#pragma unroll
                    for (int e = 0; e < 16; ++e) cnt += (key[e] >= cand) ? 1 : 0;
                    cnt = sum_jg(cnt);
                    if (cnt >= 13) Tt = cand;
                }
                int cgt = 0, ceq = 0;
#pragma unroll
                for (int e = 0; e < 16; ++e) { cgt += (key[e] > Tt) ? 1 : 0; ceq += (key[e] == Tt) ? 1 : 0; }
                cgt = sum_jg(cgt);
                const int need = 13 - cgt;
                int run = 0;
#pragma unroll
                for (int j2 = 0; j2 < 8; ++j2) { const int c = __shfl(ceq, qi + 8 * j2); if (j2 < jg) run += c; }
#pragma unroll
                for (int e = 0; e < 16; ++e) {
                    if (key[e] > Tt) m16 |= 1u << e;
                    else if (key[e] == Tt) { if (run < need) m16 |= 1u << e; ++run; }
                }
#pragma unroll
                for (int e = 0; e < 16; ++e) { const int j = 16 * jg + e; if (j == 0 || j == qb || j == qb - 1) m16 |= 1u << e; }
            }
            sel[0] = sel[1] = sel[2] = sel[3] = 0u;
#pragma unroll
            for (int j2 = 0; j2 < 8; ++j2) { const unsigned v = (unsigned)__shfl((int)m16, qi + 8 * j2); sel[j2 >> 1] |= v << (16 * (j2 & 1)); }
        }
        if (lane < 8) {
#pragma unroll
            for (int k4 = 0; k4 < 4; ++k4) selw[k4] = sel[k4];
        }
        unsigned wu[4];
#pragma unroll
        for (int k4 = 0; k4 < 4; ++k4) { unsigned x = sel[k4]; x |= (unsigned)__shfl_xor((int)x, 1); x |= (unsigned)__shfl_xor((int)x, 2); x |= (unsigned)__shfl_xor((int)x, 4); wu[k4] = (unsigned)__builtin_amdgcn_readfirstlane((int)x); if (lane == 0) wun[w * 4 + k4] = x; }
        __syncthreads();
        unsigned un[4] = {0u, 0u, 0u, 0u};
#pragma unroll
        for (int w2 = 0; w2 < 8; ++w2)
#pragma unroll
            for (int k4 = 0; k4 < 4; ++k4) un[k4] |= wun[w2 * 4 + k4];
#pragma unroll
        for (int k4 = 0; k4 < 4; ++k4) un[k4] = (unsigned)__builtin_amdgcn_readfirstlane((int)un[k4]);
        const int nslc = __popc(un[0]) + __popc(un[1]) + __popc(un[2]) + __popc(un[3]);
        const int jw0 = qb >= 8 ? qb - 8 : 0, nwin = qb - jw0 + 1, n2 = nslc + nwin;
        int tidl = tid; asm volatile("" : "+v"(tidl));
        if (tidl < 128) {
            const int j = tidl, wd = j >> 5, bi = j & 31;
            const unsigned uw = pick4(un, wd);
            if ((uw >> bi) & 1u) {
                int pos = __popc(uw & ((1u << bi) - 1u));
#pragma unroll
                for (int k4 = 0; k4 < 4; ++k4) if (k4 < wd) pos += __popc(un[k4]);
                tl[nslc - 1 - pos] = (unsigned short)j;
            }
        } else if (tidl < 128 + nwin) tl[nslc + (tidl - 128)] = (unsigned short)(0x100 | (qb - (tidl - 128)));
        __syncthreads();
        {
            skmul = 1.f;
#define ATT_DMA2(idx, buf) do { const int _e = tl[idx]; const int _j = _e & 0xff; const bool _w = _e >> 8; \
                ATT_DMA((_w ? kwin : kslc) + ((size_t)bgi * SEQ + 64 * _j) * 64, (_w ? vwin : vslc) + ((size_t)bgi * 128 + _j) * 4096, buf); } while (0)
            ATT_DMA2(0, 0);
            ATT_DMA2(1, 1);
            int cb = 0;
            for (int i = 0; i < n2; ++i) {
                ATT_WAIT(i + 1 < n2);
                if (i + 2 < n2) { const int nb = cb == 0 ? 2 : cb - 1; ATT_DMA2(i + 2, nb); }
                const int buf3 = cb; cb = cb == 2 ? 0 : cb + 1;
                const int e = tl[i];
                const int j = e & 0xff; const bool isw = e >> 8;
#pragma unroll
                for (int ct = 0; ct < 2; ++ct) lb[ct] = slope2[ct] * ((float)(64 * j + 4 * slab) - (float)t);
                const LAS bf16_t* Kb = Ksm + buf3 * 4096; const LAS bf16_t* Vb = Vsm + buf3 * 4096;
                if (isw && i == nslc) {
#pragma unroll
                    for (int ct = 0; ct < 2; ++ct) { float lt = xsum_16_32(l[ct]);
                        const float sc1 = (lt > 0.f ? fast_rcp(lt) : 0.f) * gates[(size_t)tok * 48 + hh[ct] * 3 + 1];
#pragma unroll
                        for (int dt = 0; dt < 4; ++dt) { ofin[(ct * 4 + dt) * 512] += O[ct][dt] * sc1; O[ct][dt] = (f32x4){0.f, 0.f, 0.f, 0.f}; }
                        m[ct] = -1e20f; l[ct] = 0.f; }
                }
                int tlo = 0, thi = 63; bool active = true, domask = false;
                if (!isw) {
                    active = (pick4(wu, j >> 5) >> (j & 31)) & 1u;
                    const bool cval = (selw[j >> 5] >> (j & 31)) & 1u;
                    thi = cval ? (j == qb ? ql : 63) : -1;
                    domask = (j == qb) || !__all(cval);
                } else {
                    if (j == qb) { thi = ql; domask = true; }
                    else if (j == qb - 8) { tlo = ql + 1; domask = true; }
                }
                if (active) {
                    if (domask) attn_tile<true, 0>(Kb, Vb, qf, O, m, l, lb, slope2, skmul, tlo, thi, col, slab, imp_row, 0);
                    else attn_tile<false, 0>(Kb, Vb, qf, O, m, l, lb, slope2, skmul, 0, 63, col, slab, imp_row, 0);
                }
            }
        }
#pragma unroll
        for (int ct = 0; ct < 2; ++ct) { float lt = xsum_16_32(l[ct]);
            const float sc2 = (lt > 0.f ? fast_rcp(lt) : 0.f) * gates[(size_t)tok * 48 + hh[ct] * 3 + 2];
#pragma unroll
            for (int dt = 0; dt < 4; ++dt) {
                const f32x4 o = ofin[(ct * 4 + dt) * 512] + O[ct][dt] * sc2;
                u32x2 wv2; wv2.x = cvt_pk_bf16(o[0], o[1]); wv2.y = cvt_pk_bf16(o[2], o[3]);
                *(u32x2*)(obuf + (size_t)tok * 1024 + hh[ct] * 64 + 16 * dt + 4 * slab) = wv2;
            } }
        if (tid == 0) qslot[0] = nxt_ui;
        __syncthreads();
        ui = __builtin_amdgcn_readfirstlane(qslot[0]);
    }
}

__device__ __forceinline__ void final_phase(const Params& p) {
    float* out = p.out; const bf16_t* hb = (const bf16_t*)(p.ws + WS_HB); const float* part = (const float*)(p.ws + WS_PART) + (size_t)4 * T * 16; const float* gn = p.in[19];
    const int lane = threadIdx.x & 63, wv = threadIdx.x >> 6;
    for (int r = blockIdx.x * 8 + wv; r < T; r += gridDim.x * 8) {
        const float rs = row_rstd(part, r);
#pragma unroll
        for (int j = 0; j < 2; ++j) {
            const u32x4 w = *(const u32x4*)(hb + (size_t)r * 1024 + j * 512 + lane * 8);
            const f32x4 g0 = *(const f32x4*)(gn + j * 512 + lane * 8), g1 = *(const f32x4*)(gn + j * 512 + lane * 8 + 4);
            f32x4* o = (f32x4*)(out + (size_t)r * 1024 + j * 512 + lane * 8);
            __builtin_nontemporal_store((f32x4){bf_lo(w.x), bf_hi(w.x), bf_lo(w.y), bf_hi(w.y)} * rs * g0, o);
            __builtin_nontemporal_store((f32x4){bf_lo(w.z), bf_hi(w.z), bf_lo(w.w), bf_hi(w.w)} * rs * g1, o + 1);
        }
    }
}

#define XB_TMO      128
#define XB_XCNT(j)  (256  + 64 * (j))
#define XB_XSUB(j)  (1280 + 64 * (j))
#define XB_XGEN(j)  (2304 + 64 * (j))
#define XB_TOP      3328
#define XB_TOPGEN   3392
#define XCD_BAR_WORDS 3456
#define XB_SPIN_CAP (1u << 18)
__device__ __forceinline__ unsigned xb_ld(unsigned* p)              { return __hip_atomic_load(p, __ATOMIC_RELAXED, __HIP_MEMORY_SCOPE_AGENT); }
__device__ __forceinline__ unsigned xb_add(unsigned* p, unsigned v) { return __hip_atomic_fetch_add(p, v, __ATOMIC_RELAXED, __HIP_MEMORY_SCOPE_AGENT); }
__device__ __forceinline__ unsigned xb_xcc_id() { return (unsigned)__builtin_amdgcn_s_getreg((3 << 11) | 20) & 0xFu; }
#define XB_SPIN(cond, bar) do { unsigned _sp = 0; while (cond) { __builtin_amdgcn_s_sleep(1); \
    if ((++_sp & 255u) == 0u) { if (xb_ld(&(bar)[XB_TMO])) break; if (_sp > XB_SPIN_CAP) { atomicAdd(&(bar)[XB_TMO], 1u); break; } } } } while (0)
struct XcdBarrier { unsigned* bar; unsigned x; volatile LAS unsigned* st; };
__device__ __forceinline__ XcdBarrier xcd_barrier_post(unsigned* bar, volatile LAS unsigned* st) {
    XcdBarrier b; b.bar = bar; b.x = xb_xcc_id(); b.st = st;
    if (threadIdx.x == 0) (void)xb_add(&bar[XB_XCNT(b.x)], 1u);
    return b;
}
__device__ __forceinline__ void xcd_barrier_complete(unsigned* bar, unsigned x, unsigned& nloc, unsigned& nx) {
    const unsigned G = gridDim.x * gridDim.y * gridDim.z;
    unsigned sum, cnt, mine, sp = 0u;
    for (;;) {
        sum = 0u; cnt = 0u; mine = 0u;
#pragma unroll
        for (unsigned j = 0; j < 16; ++j) { const unsigned c = xb_ld(&bar[XB_XCNT(j)]); sum += c; cnt += (c > 0u) ? 1u : 0u; mine = (j == x) ? c : mine; }
        if (sum == G) break;
        __builtin_amdgcn_s_sleep(1);
        if ((++sp & 255u) == 0u) { if (xb_ld(&bar[XB_TMO])) break; if (sp > XB_SPIN_CAP) { atomicAdd(&bar[XB_TMO], 1u); break; } }
    }
    nloc = mine > 0u ? mine : 1u; nx = cnt > 0u ? cnt : 1u;
}
__device__ __forceinline__ void xcd_barrier(const XcdBarrier& b) {
    asm volatile("s_waitcnt vmcnt(0)" ::: "memory");
    __syncthreads();
    if (threadIdx.x == 0) {
        unsigned* bar = b.bar;
        __builtin_amdgcn_s_waitcnt(0);
        unsigned nloc = b.st[0], nx = b.st[1];
        if (nloc == 0u) { xcd_barrier_complete(bar, b.x, nloc, nx); b.st[0] = nloc; b.st[1] = nx; }
        const unsigned old = xb_add(&bar[XB_XSUB(b.x)], 1u);
        const unsigned gen = old / nloc;
        if (old + 1u == (gen + 1u) * nloc) {
            __builtin_amdgcn_fence(__ATOMIC_RELEASE, "agent");
            asm volatile("s_waitcnt vmcnt(0)" ::: "memory");
            const unsigned og = xb_add(&bar[XB_TOP], 1u);
            const unsigned tg = og / nx;
            if (og + 1u == (tg + 1u) * nx) xb_add(&bar[XB_TOPGEN], 1u);
            else XB_SPIN(xb_ld(&bar[XB_TOPGEN]) == tg, bar);
            __builtin_amdgcn_fence(__ATOMIC_ACQUIRE, "agent");
            xb_add(&bar[XB_XGEN(b.x)], 1u);
            asm volatile("s_waitcnt vmcnt(0)" ::: "memory");
        } else {
            XB_SPIN(xb_ld(&bar[XB_XGEN(b.x)]) == gen, bar);
            __builtin_amdgcn_fence(__ATOMIC_ACQUIRE, "agent");
            asm volatile("s_waitcnt vmcnt(0)" ::: "memory");
        }
    }
    __syncthreads();
}

__global__ void __launch_bounds__(512, 2) fwd_megakernel(Params p) {
    extern __shared__ __attribute__((aligned(16))) unsigned char smem[];
    LAS unsigned char* lds = (LAS unsigned char*)smem;
    cg::grid_group grid = cg::this_grid();
    unsigned char* ws = p.ws;
    float* part = (float*)(ws + WS_PART);
    const int G = gridDim.x, bx = blockIdx.x;
    const int lo = p.ph_lo, hi = p.ph_hi;
#ifndef PH_MASK
#define PH_MASK 0xffff
#endif
#define IN(k) (((PH_MASK >> (k)) & 1) && lo <= (k) && (k) < hi)
    volatile LAS unsigned* xst = (volatile LAS unsigned*)(lds + LDS_BYTES - 16);
    if (threadIdx.x == 0) { xst[0] = 0u; xst[1] = 0u; }
    __syncthreads();
    XcdBarrier xbar; xbar.bar = (unsigned*)(ws + WS_BAR); xbar.x = 0u; xbar.st = xst;
#define SEAM(k) do { if (IN(k) && IN((k) + 1)) { if ((k) == 0) { grid.sync(); xbar = xcd_barrier_post((unsigned*)(ws + WS_BAR), xst); } else xcd_barrier(xbar); } } while (0)
    if (IN(0)) prep_phase(p, lds);
    SEAM(0);
    if (IN(1)) { pg8::Gemm g{(const bf16_t*)(ws + WS_HB), (const bf16_t*)(ws + WS_WIN), 1024, 1024}; pg8::StaticOrder S; S.init(T, 3072, G, bx);
        EpiWin E{part, (bf16_t*)(ws + WS_CV), (bf16_t*)(ws + WS_BG)}; pg8::gemm_phase(lds, g, S, E); }
    SEAM(1);
    if (IN(2)) conv_phase(p);
    SEAM(2);
    if (IN(3)) { pg8::Gemm g{(const bf16_t*)(ws + WS_U), (const bf16_t*)(ws + WS_WOUT), 1024, 1024}; pg8::StaticOrder S; S.init(T, 1024, G, bx);
        EpiResB E{(bf16_t*)(ws + WS_HB), part + (size_t)1 * T * 16}; pg8::gemm_phase(lds, g, S, E); }
    SEAM(3);
    if (IN(4)) { pg8::Gemm g{(const bf16_t*)(ws + WS_HB), (const bf16_t*)(ws + WS_WGU0), 1024, 1024}; pg8::StaticOrder S; S.init(T, 5632, G, bx);
        EpiGu E{part + (size_t)1 * T * 16, (bf16_t*)(ws + WS_HID)}; pg8::gemm_phase(lds, g, S, E); }
    SEAM(4);
    if (IN(5)) { pg8::Gemm g{(const bf16_t*)(ws + WS_HID), (const bf16_t*)(ws + WS_WDN0), FF, FF}; pg8::StaticOrder S; S.init(T, 1024, G, bx);
        EpiResB E{(bf16_t*)(ws + WS_HB), part + (size_t)2 * T * 16}; pg8::gemm_phase(lds, g, S, E); }
    SEAM(5);
    if (IN(6)) { pg8::Gemm g{(const bf16_t*)(ws + WS_HB), (const bf16_t*)(ws + WS_WKVQG), 1024, 1024}; pg8::StaticOrder S; S.init(T, 2560, G, bx);
        EpiKvqg E{part + (size_t)2 * T * 16, ws}; pg8::gemm_phase(lds, g, S, E); }
    SEAM(6);
    if (IN(7)) {
        const bool split = G >= 256;
        if (!split || bx < 128) { pg8::Gemm g{(const bf16_t*)(ws + WS_CMPRAW), (const bf16_t*)(ws + WS_WC1), 1024, 1024}; pg8::CmpOrder S{split ? 128 : G, bx};
            EpiCmp E{(bf16_t*)(ws + WS_O)}; pg8::gemm_phase(lds, g, S, E); }
        if (!split || bx >= 128) { pg8::Gemm g{(const bf16_t*)(ws + WS_HB), (const bf16_t*)(ws + WS_WKVQG), 1024, 1024}; pg8::GateOrder S{split ? G - 128 : G, split ? bx - 128 : bx};
            EpiKvqg E{part + (size_t)2 * T * 16, ws}; pg8::gemm_phase(lds, g, S, E); }
    }
    SEAM(7);
    if (IN(8)) cmp2_phase(p);
    SEAM(8);
    if (IN(9)) attn_phase(p, lds);
    SEAM(9);
    if (IN(10)) { pg8::Gemm g{(const bf16_t*)(ws + WS_O), (const bf16_t*)(ws + WS_WO), 1024, 1024}; pg8::StaticOrder S; S.init(T, 1024, G, bx);
        EpiResB E{(bf16_t*)(ws + WS_HB), part + (size_t)3 * T * 16}; pg8::gemm_phase(lds, g, S, E); }
    SEAM(10);
    if (IN(11)) { pg8::Gemm g{(const bf16_t*)(ws + WS_HB), (const bf16_t*)(ws + WS_WGU1), 1024, 1024}; pg8::StaticOrder S; S.init(T, 5632, G, bx);
        EpiGu E{part + (size_t)3 * T * 16, (bf16_t*)(ws + WS_HID)}; pg8::gemm_phase(lds, g, S, E); }
    SEAM(11);
    if (IN(12)) { pg8::Gemm g{(const bf16_t*)(ws + WS_HID), (const bf16_t*)(ws + WS_WDN1), FF, FF}; pg8::StaticOrder S; S.init(T, 1024, G, bx);
        EpiResB E{(bf16_t*)(ws + WS_HB), part + (size_t)4 * T * 16}; pg8::gemm_phase(lds, g, S, E); }
    SEAM(12);
    if (IN(13)) final_phase(p);
#ifdef DUMP_BASE
    SEAM(13);
    if (lo <= 14 && 14 < hi) {
        const unsigned short* src = (const unsigned short*)(ws + (size_t)(DUMP_BASE));
        const size_t n = (size_t)T * 1024;
        for (size_t i = (size_t)bx * 512 + threadIdx.x; i < n; i += (size_t)G * 512) p.out[i] = (float)src[i] + (float)src[i + n] + (float)src[i + 2 * n];
    }
#endif
}

#ifdef DUMP_BASE
constexpr int N_PHASES = 15;
#else
constexpr int N_PHASES = 14;
#endif
#ifndef N_LAUNCH_SPLIT
#define N_LAUNCH_SPLIT 0
#endif
extern "C" void kernel_launch(void* const* d_in, const int* in_sizes, int n_in, void* d_out, int out_size, void* d_ws, size_t ws_size, hipStream_t stream) {
    static int grid_blocks = 0;
    if (!grid_blocks) {
        int dev = 0, cus = 0, per_cu = 0;
        hipGetDevice(&dev);
        hipDeviceGetAttribute(&cus, hipDeviceAttributeMultiprocessorCount, dev);
        hipFuncSetAttribute((const void*)fwd_megakernel, hipFuncAttributeMaxDynamicSharedMemorySize, LDS_BYTES);
        hipOccupancyMaxActiveBlocksPerMultiprocessor(&per_cu, (const void*)fwd_megakernel, 512, LDS_BYTES);
        if (per_cu < 1) { fprintf(stderr, "occupancy query returned %d\n", per_cu); per_cu = 1; }
        grid_blocks = cus * 1;
    }
    Params p{};
    for (int i = 0; i < 20; ++i) p.in[i] = (const float*)d_in[i];
    p.out = (float*)d_out; p.ws = (unsigned char*)d_ws;
#if N_LAUNCH_SPLIT
    for (int ph = 0; ph < N_PHASES; ++ph) {
        p.ph_lo = ph; p.ph_hi = ph + 1;
        void* args[] = {&p};
        hipError_t e = hipLaunchCooperativeKernel((const void*)fwd_megakernel, dim3(grid_blocks), dim3(512), args, LDS_BYTES, stream);
        if (e != hipSuccess) fprintf(stderr, "cooperative launch failed: %s (grid %d)\n", hipGetErrorString(e), grid_blocks);
    }
#else
    p.ph_lo = 0; p.ph_hi = N_PHASES;
    void* args[] = {&p};
    hipError_t e = hipLaunchCooperativeKernel((const void*)fwd_megakernel, dim3(grid_blocks), dim3(512), args, LDS_BYTES, stream);
    if (e != hipSuccess) fprintf(stderr, "cooperative launch failed: %s (grid %d)\n", hipGetErrorString(e), grid_blocks);
#endif
}
```
